# Optimizing an MI355X kernel written in HIP

```python
import math
import jax, jax.numpy as jnp
from jax import lax
import numpy as np

D_MODEL = 1024
BATCH = 8
SEQ = 2048
DEPTH = 1

ATT_HEADS = 8
ATT_KV_HEADS = 2
HEAD_DIM = 64
WINDOW = 128
BLOCK = 128
ATT_Q = ATT_HEADS * HEAD_DIM
ATT_KV = ATT_KV_HEADS * HEAD_DIM
GLA_HEADS = 4
GLA_DK = 64
GLA_DV = 128
GLA_RANK = 16
GLA_NORMALIZER = 16.0
GLA_CHUNK = 16
GLA_K = GLA_HEADS * GLA_DK
GLA_V = GLA_HEADS * GLA_DV
MIX_WIDTH = ATT_Q + GLA_V
IN_COLS = ATT_Q + 2 * ATT_KV + 2 * GLA_K + GLA_V + GLA_RANK + GLA_V
N_GROUPS = 4
EXPERTS_PER_GROUP = 4
N_EXPERTS = N_GROUPS * EXPERTS_PER_GROUP
TOP_K = 2
D_EXPERT = 256
EPS = 1e-6

kernel_name = "hymba_swa_sink_gla_hier_moe_adaln"


def rms_norm(x, g):
    xf = x.astype(jnp.float32)
    y = xf * lax.rsqrt(jnp.mean(xf * xf, axis=-1, keepdims=True) + EPS)
    return (y * g.astype(jnp.float32)).astype(x.dtype)


def alibi_slopes(n_heads):
    h = jnp.arange(1, n_heads + 1, dtype=jnp.float32)
    return jnp.exp2(-8.0 * h / n_heads)


def sliding_window_attention(q, k, v, sinks):
    B, T, Hq, hd = q.shape
    Hkv = k.shape[2]
    G = Hq // Hkv
    nb = T // BLOCK
    f32 = jnp.float32
    qb = q.reshape(B, nb, BLOCK, Hkv, G, hd)

    def banded(t):
        prev = jnp.concatenate([jnp.zeros_like(t[:, :BLOCK]), t[:, :-BLOCK]], axis=1)
        return jnp.concatenate([prev.reshape(B, nb, BLOCK, Hkv, hd),
                                t.reshape(B, nb, BLOCK, Hkv, hd)], axis=2)

    kb, vb = banded(k), banded(v)
    s = jnp.einsum('bnqhgd,bnkhd->bnhgqk', qb, kb).astype(f32) * (hd ** -0.5)
    qi = jnp.arange(BLOCK)[:, None]
    kj = jnp.arange(2 * BLOCK)[None, :]
    dist = qi - kj + BLOCK
    blk = jnp.arange(nb)[:, None, None]
    valid = (dist >= 0) & (dist < WINDOW) & (blk * BLOCK + kj - BLOCK >= 0)
    slopes = alibi_slopes(Hq).reshape(Hkv, G)[:, :, None, None]
    s = s - slopes * dist.astype(f32)
    s = jnp.where(valid[None, :, None, None], s, -jnp.inf)
    sk = sinks.astype(f32).reshape(Hkv, G)[:, :, None, None]
    m = jnp.maximum(jnp.max(s, axis=-1, keepdims=True), sk)
    p = jnp.exp(s - m)
    p = p / (jnp.sum(p, axis=-1, keepdims=True) + jnp.exp(sk - m))
    o = jnp.einsum('bnhgqk,bnkhd->bnqhgd', p.astype(v.dtype), vb)
    return o.reshape(B, T, Hq * hd)


def gla_chunked(q, k, v, log_a):
    B, T, H, dk = q.shape
    dv = v.shape[-1]
    C = GLA_CHUNK
    n = T // C
    f32 = jnp.float32
    q = q.astype(f32).reshape(B, n, C, H, dk) * (dk ** -0.5)
    k = k.astype(f32).reshape(B, n, C, H, dk)
    v = v.astype(f32).reshape(B, n, C, H, dv)
    b = jnp.cumsum(log_a.astype(f32).reshape(B, n, C, H, dk), axis=2)
    causal = jnp.tril(jnp.ones((C, C), dtype=bool))
    diff = b[:, :, :, None] - b[:, :, None, :]
    decay = jnp.where(causal[:, :, None, None], jnp.exp(jnp.minimum(diff, 0.0)), 0.0)
    attn = jnp.einsum('bnijhd,bnjhd->bnhij', q[:, :, :, None] * decay, k)
    o_intra = jnp.einsum('bnhij,bnjhe->bnihe', attn, v)
    b_last = b[:, :, -1]
    q_dec = q * jnp.exp(b)
    k_dec = k * jnp.exp(b_last[:, :, None] - b)
    u = jnp.einsum('bnjhd,bnjhe->bnhde', k_dec, v)

    def step(S, inp):
        a, du = inp
        return a[..., None] * S + du, S

    S0 = jnp.zeros((B, H, dk, dv), f32)
    _, S_prev = lax.scan(step, S0, (jnp.moveaxis(jnp.exp(b_last), 1, 0), jnp.moveaxis(u, 1, 0)))
    S_prev = jnp.moveaxis(S_prev, 0, 1)
    o_inter = jnp.einsum('bnihd,bnhde->bnihe', q_dec, S_prev)
    return (o_intra + o_inter).reshape(B, T, H, dv)


def hier_moe(h, w_group, b_group, w_router, b_router, w1, w3, w2):
    B, T, D = h.shape
    N = B * T
    hf = h.reshape(N, D)
    g_logits = (hf @ w_group + b_group).astype(jnp.float32)
    g_prob = jax.nn.softmax(g_logits, axis=-1)
    g_sel = jnp.argmax(g_logits, axis=-1)
    p_group = jnp.take_along_axis(g_prob, g_sel[:, None], axis=-1)
    e_logits = (hf @ w_router + b_router).astype(jnp.float32).reshape(N, N_GROUPS, EXPERTS_PER_GROUP)
    e_logits = jnp.take_along_axis(e_logits, g_sel[:, None, None], axis=1)[:, 0]
    e_prob = jax.nn.softmax(e_logits, axis=-1)
    top_v, top_i = lax.top_k(e_prob, TOP_K)
    top_v = top_v / jnp.sum(top_v, axis=-1, keepdims=True)
    expert_idx = g_sel[:, None] * EXPERTS_PER_GROUP + top_i
    weights = p_group * top_v
    combine = jnp.sum(jax.nn.one_hot(expert_idx, N_EXPERTS, dtype=jnp.float32) * weights[..., None], axis=1)
    a = jnp.einsum('nd,edf->nef', hf, w1)
    g = jnp.einsum('nd,edf->nef', hf, w3)
    hid = jax.nn.silu(a) * g * combine.astype(hf.dtype)[..., None]
    y = jnp.einsum('nef,efd->nd', hid, w2)
    return y.reshape(B, T, D)


def setup_inputs(seed: int = 0) -> dict:
    key = jax.random.key(seed)
    ks = jax.random.split(key, 24)
    D, L = D_MODEL, DEPTH
    nrm = lambda k, shape, s: jax.random.normal(k, shape, jnp.float32) * s
    return {
        "x": nrm(ks[0], (BATCH, SEQ, D), 1.0),
        "c": nrm(ks[1], (BATCH, D), 1.0),
        "w_ada": nrm(ks[2], (L, D, 6 * D), D ** -0.5),
        "b_ada": nrm(ks[3], (L, 6 * D), 0.02),
        "g_norm1": 1.0 + nrm(ks[4], (L, D), 0.02),
        "w_in": nrm(ks[5], (L, D, IN_COLS), D ** -0.5),
        "q_norm": 1.0 + nrm(ks[6], (L, HEAD_DIM), 0.02),
        "k_norm": 1.0 + nrm(ks[7], (L, HEAD_DIM), 0.02),
        "sinks": nrm(ks[8], (L, ATT_HEADS), 1.0),
        "w_gk2": nrm(ks[9], (L, GLA_RANK, GLA_K), GLA_RANK ** -0.5),
        "b_gk": nrm(ks[10], (L, GLA_K), 0.1),
        "g_gla_out": 1.0 + nrm(ks[11], (L, GLA_DV), 0.02),
        "g_att_out": 1.0 + nrm(ks[12], (L, ATT_Q), 0.02),
        "w_out": nrm(ks[13], (L, MIX_WIDTH, D), MIX_WIDTH ** -0.5),
        "g_norm2": 1.0 + nrm(ks[14], (L, D), 0.02),
        "w_group": nrm(ks[15], (L, D, N_GROUPS), D ** -0.5),
        "b_group": nrm(ks[16], (L, N_GROUPS), 0.01),
        "w_router": nrm(ks[17], (L, D, N_EXPERTS), D ** -0.5),
        "b_router": nrm(ks[18], (L, N_EXPERTS), 0.01),
        "w1": nrm(ks[19], (L, N_EXPERTS, D, D_EXPERT), D ** -0.5),
        "w3": nrm(ks[20], (L, N_EXPERTS, D, D_EXPERT), D ** -0.5),
        "w2": nrm(ks[21], (L, N_EXPERTS, D_EXPERT, D), D_EXPERT ** -0.5),
    }


def reference(x, c, w_ada, b_ada, g_norm1, w_in, q_norm, k_norm, sinks, w_gk2, b_gk,
              g_gla_out, g_att_out, w_out, g_norm2, w_group, b_group, w_router, b_router,
              w1, w3, w2):
    B, T, D = x.shape
    split_points = list(np.cumsum([ATT_Q, ATT_KV, ATT_KV, GLA_K, GLA_K, GLA_V, GLA_RANK]))
    for l in range(DEPTH):
        mod = (jax.nn.silu(c) @ w_ada[l] + b_ada[l]).reshape(B, 6, D)[:, :, None, :]
        shift1, scale1, gate1, shift2, scale2, gate2 = [mod[:, i] for i in range(6)]

        h = rms_norm(x, g_norm1[l]) * (1.0 + scale1) + shift1
        proj = h @ w_in[l]
        q_a, k_a, v_a, q_g, k_g, v_g, lr_g, og_g = jnp.split(proj, split_points, axis=-1)
        q_a = rms_norm(q_a.reshape(B, T, ATT_HEADS, HEAD_DIM), q_norm[l])
        k_a = rms_norm(k_a.reshape(B, T, ATT_KV_HEADS, HEAD_DIM), k_norm[l])
        v_a = v_a.reshape(B, T, ATT_KV_HEADS, HEAD_DIM)
        y_att = rms_norm(sliding_window_attention(q_a, k_a, v_a, sinks[l]), g_att_out[l])
        log_a = jax.nn.log_sigmoid((lr_g @ w_gk2[l] + b_gk[l]).astype(jnp.float32)) / GLA_NORMALIZER
        o_g = gla_chunked(q_g.reshape(B, T, GLA_HEADS, GLA_DK),
                          k_g.reshape(B, T, GLA_HEADS, GLA_DK),
                          v_g.reshape(B, T, GLA_HEADS, GLA_DV),
                          log_a.reshape(B, T, GLA_HEADS, GLA_DK)).astype(x.dtype)
        o_g = rms_norm(o_g, g_gla_out[l]).reshape(B, T, GLA_V)
        y_gla = o_g * jax.nn.silu(og_g)
        mix = jnp.concatenate([y_att, y_gla], axis=-1) @ w_out[l]
        x = x + gate1 * mix

        h = rms_norm(x, g_norm2[l]) * (1.0 + scale2) + shift2
        y = hier_moe(h, w_group[l], b_group[l], w_router[l], b_router[l], w1[l], w3[l], w2[l])
        x = x + gate2 * y
    return x
```

```cpp
#include <hip/hip_runtime.h>
#include <cstdio>
#include <cstdint>
#include <cmath>
namespace nv {
constexpr int D = 1024, B = 8, T = 2048, M = B * T;
constexpr int INC = 2320;
constexpr int C_QA = 0, C_KA = 512, C_VA = 640, C_QG = 768, C_KG = 1024, C_VG = 1280, C_LR = 1792, C_OG = 1808;

__device__ __forceinline__ float siluf(float v) { return v / (1.f + __expf(-v)); }

__global__ void k_mod(const float* __restrict__ c, const float* __restrict__ W, const float* __restrict__ bias, float* __restrict__ mod) {
    const int j = blockIdx.x * blockDim.x + threadIdx.x; const int b = blockIdx.y;
    if (j >= 6 * D) return;
    float acc = 0.f;
    for (int k = 0; k < D; ++k) acc += siluf(c[b * D + k]) * W[(size_t)k * 6 * D + j];
    mod[b * 6 * D + j] = acc + bias[j];
}
__global__ void k_normmod(const float* __restrict__ x, const float* __restrict__ g, const float* __restrict__ mod, int i_shift, int i_scale, float* __restrict__ h) {
    __shared__ float red[256];
    const int t = blockIdx.x, b = t / T, tid = threadIdx.x;
    float v[4]; float s = 0.f;
    for (int i = 0; i < 4; ++i) { v[i] = x[(size_t)t * D + tid + 256 * i]; s += v[i] * v[i]; }
    red[tid] = s; __syncthreads();
    for (int o = 128; o > 0; o >>= 1) { if (tid < o) red[tid] += red[tid + o]; __syncthreads(); }
    const float rstd = rsqrtf(red[0] / D + 1e-6f);
    for (int i = 0; i < 4; ++i) { const int k = tid + 256 * i;
        h[(size_t)t * D + k] = v[i] * rstd * g[k] * (1.f + mod[b * 6 * D + i_scale * D + k]) + mod[b * 6 * D + i_shift * D + k]; }
}
__global__ void k_gemm(const float* __restrict__ A, int lda, const float* __restrict__ Bm, int ldb, float* __restrict__ C, int ldc, int Mm, int N, int K) {
    __shared__ float sA[16][64 + 1]; __shared__ float sB[16][64 + 1];
    const int tx = threadIdx.x & 15, ty = threadIdx.x >> 4, m0 = blockIdx.y * 64, n0 = blockIdx.x * 64;
    float acc[4][4] = {};
    for (int k0 = 0; k0 < K; k0 += 16) {
        for (int e = threadIdx.x; e < 64 * 16; e += 256) { const int r = e >> 4, kk = e & 15; sA[kk][r] = A[(size_t)(m0 + r) * lda + k0 + kk]; }
        for (int e = threadIdx.x; e < 64 * 16; e += 256) { const int kk = e >> 6, cc = e & 63; sB[kk][cc] = (n0 + cc < N) ? Bm[(size_t)(k0 + kk) * ldb + n0 + cc] : 0.f; }
        __syncthreads();
#pragma unroll
        for (int kk = 0; kk < 16; ++kk) { float a[4], bb[4];
#pragma unroll
            for (int i = 0; i < 4; ++i) { a[i] = sA[kk][ty * 4 + i]; bb[i] = sB[kk][tx * 4 + i]; }
#pragma unroll
            for (int i = 0; i < 4; ++i)
#pragma unroll
                for (int j = 0; j < 4; ++j) acc[i][j] += a[i] * bb[j]; }
        __syncthreads();
    }
    for (int i = 0; i < 4; ++i) for (int j = 0; j < 4; ++j) { const int n = n0 + tx * 4 + j; if (n < N) C[(size_t)(m0 + ty * 4 + i) * ldc + n] = acc[i][j]; }
}
__global__ void k_headnorm(float* __restrict__ proj, int col0, int nheads, const float* __restrict__ g) {
    const int gw = (blockIdx.x * blockDim.x + threadIdx.x) >> 6, lane = threadIdx.x & 63;
    if (gw >= M * nheads) return;
    const int t = gw / nheads, hh = gw % nheads;
    float* p = proj + (size_t)t * INC + col0 + hh * 64;
    const float v = p[lane]; float s = v * v;
    for (int o = 32; o > 0; o >>= 1) s += __shfl_xor(s, o);
    p[lane] = v * rsqrtf(s / 64.f + 1e-6f) * g[lane];
}
__global__ void k_attn(const float* __restrict__ proj, const float* __restrict__ sinks, float* __restrict__ cat) {
    const int gw = (blockIdx.x * blockDim.x + threadIdx.x) >> 6, lane = threadIdx.x & 63;
    if (gw >= M * 8) return;
    const int tg = gw / 8, hq = gw % 8, b = tg / T, t = tg % T, kvh = hq / 4;
    const float slope = exp2f(-(float)(hq + 1));
    const float* q = proj + (size_t)tg * INC + C_QA + hq * 64;
    float sc[2];
    for (int i = 0; i < 2; ++i) { const int dist = lane + 64 * i; const int s = t - dist;
        if (s >= 0) { const float* kp = proj + (size_t)(b * T + s) * INC + C_KA + kvh * 64; float a = 0.f; for (int d = 0; d < 64; ++d) a += q[d] * kp[d]; sc[i] = a * 0.125f - slope * (float)dist; }
        else sc[i] = -INFINITY; }
    float m = fmaxf(sc[0], sc[1]);
    for (int o = 32; o > 0; o >>= 1) m = fmaxf(m, __shfl_xor(m, o));
    const float sk = sinks[hq]; m = fmaxf(m, sk);
    float p[2]; p[0] = __expf(sc[0] - m); p[1] = __expf(sc[1] - m);
    float l = p[0] + p[1];
    for (int o = 32; o > 0; o >>= 1) l += __shfl_xor(l, o);
    l += __expf(sk - m);
    float o = 0.f;
    for (int i = 0; i < 2; ++i) for (int src = 0; src < 64; ++src) { const float ps = __shfl(p[i], src); const int s = t - (src + 64 * i);
        if (s >= 0) o += ps * proj[(size_t)(b * T + s) * INC + C_VA + kvh * 64 + lane]; }
    cat[(size_t)tg * D + hq * 64 + lane] = o / l;
}
__global__ void k_attnorm(float* __restrict__ cat, const float* __restrict__ g) {
    const int gw = (blockIdx.x * blockDim.x + threadIdx.x) >> 6, lane = threadIdx.x & 63;
    if (gw >= M) return;
    float* p = cat + (size_t)gw * D; float v[8]; float s = 0.f;
    for (int i = 0; i < 8; ++i) { v[i] = p[lane + 64 * i]; s += v[i] * v[i]; }
    for (int o = 32; o > 0; o >>= 1) s += __shfl_xor(s, o);
    const float r = rsqrtf(s / 512.f + 1e-6f);
    for (int i = 0; i < 8; ++i) p[lane + 64 * i] = v[i] * r * g[lane + 64 * i];
}
__global__ void k_loga(const float* __restrict__ proj, const float* __restrict__ w_gk2, const float* __restrict__ b_gk, float* __restrict__ loga) {
    const int idx = blockIdx.x * blockDim.x + threadIdx.x; if (idx >= M * 256) return;
    const int t = idx >> 8, n = idx & 255; float z = b_gk[n];
    for (int r = 0; r < 16; ++r) z += proj[(size_t)t * INC + C_LR + r] * w_gk2[r * 256 + n];
    const float ls = fminf(z, 0.f) - log1pf(__expf(-fabsf(z)));
    loga[idx] = ls / 16.f;
}
__global__ void __launch_bounds__(128) k_gla(const float* __restrict__ proj, const float* __restrict__ loga, float* __restrict__ og_out  ) {
    __shared__ float sq[64], sk[64], sa[64];
    const int b = blockIdx.x / 4, h = blockIdx.x % 4, e = threadIdx.x;
    float S[64];
#pragma unroll
    for (int d = 0; d < 64; ++d) S[d] = 0.f;
    for (int t = 0; t < T; ++t) { const size_t row = (size_t)(b * T + t);
        __syncthreads();
        if (e < 64) { sq[e] = proj[row * INC + C_QG + h * 64 + e] * 0.125f; sk[e] = proj[row * INC + C_KG + h * 64 + e]; sa[e] = __expf(loga[row * 256 + h * 64 + e]); }
        __syncthreads();
        const float v = proj[row * INC + C_VG + h * 128 + e]; float o = 0.f;
#pragma unroll
        for (int d = 0; d < 64; ++d) { S[d] = sa[d] * S[d] + sk[d] * v; o += sq[d] * S[d]; }
        og_out[row * D + 512 + h * 128 + e] = o; }
}
__global__ void k_glaout(const float* __restrict__ proj, const float* __restrict__ g, float* __restrict__ cat) {
    const int gw = (blockIdx.x * blockDim.x + threadIdx.x) >> 6, lane = threadIdx.x & 63;
    if (gw >= M * 4) return;
    const int t = gw / 4, h = gw % 4; const float* p = cat + (size_t)t * D + 512 + h * 128;
    const float v0 = p[lane], v1 = p[lane + 64]; float s = v0 * v0 + v1 * v1;
    for (int o = 32; o > 0; o >>= 1) s += __shfl_xor(s, o);
    const float r = rsqrtf(s / 128.f + 1e-6f);
    const float g0 = proj[(size_t)t * INC + C_OG + h * 128 + lane], g1 = proj[(size_t)t * INC + C_OG + h * 128 + lane + 64];
    cat[(size_t)t * D + 512 + h * 128 + lane] = v0 * r * g[lane] * siluf(g0);
    cat[(size_t)t * D + 512 + h * 128 + lane + 64] = v1 * r * g[lane + 64] * siluf(g1);
}
__global__ void k_resid(const float* __restrict__ xin, const float* __restrict__ y, const float* __restrict__ mod, int i_gate, float* __restrict__ out) {
    const size_t idx = (size_t)blockIdx.x * blockDim.x + threadIdx.x; if (idx >= (size_t)M * D) return;
    const int t = (int)(idx / D), n = (int)(idx % D), b = t / T;
    out[idx] = xin[idx] + mod[b * 6 * D + i_gate * D + n] * y[idx];
}
__global__ void k_router(const float* __restrict__ h2, const float* __restrict__ wg, const float* __restrict__ bg, const float* __restrict__ wr, const float* __restrict__ br, int* __restrict__ sel, float* __restrict__ wt) {
    const int gw = (blockIdx.x * blockDim.x + threadIdx.x) >> 6, lane = threadIdx.x & 63;
    if (gw >= M) return;
    float acc[20];
    for (int i = 0; i < 20; ++i) acc[i] = 0.f;
    for (int k = lane; k < D; k += 64) { const float hv = h2[(size_t)gw * D + k];
        for (int i = 0; i < 4; ++i) acc[i] += hv * wg[k * 4 + i];
        for (int i = 0; i < 16; ++i) acc[4 + i] += hv * wr[k * 16 + i]; }
    for (int i = 0; i < 20; ++i) for (int o = 32; o > 0; o >>= 1) acc[i] += __shfl_xor(acc[i], o);
    if (lane == 0) {
        float gl[4]; int gs = 0; for (int i = 0; i < 4; ++i) { gl[i] = acc[i] + bg[i]; if (gl[i] > gl[gs]) gs = i; }
        float den = 0.f; for (int i = 0; i < 4; ++i) den += __expf(gl[i] - gl[gs]);
        const float pg = 1.f / den;
        float el[4]; int i1 = 0; for (int i = 0; i < 4; ++i) { el[i] = acc[4 + gs * 4 + i] + br[gs * 4 + i]; if (el[i] > el[i1]) i1 = i; }
        int i2 = -1; for (int i = 0; i < 4; ++i) { if (i == i1) continue; if (i2 < 0 || el[i] > el[i2]) i2 = i; }
        const float p1 = 1.f, p2 = __expf(el[i2] - el[i1]);
        sel[gw * 2] = gs * 4 + i1; sel[gw * 2 + 1] = gs * 4 + i2; wt[gw * 2] = pg * p1 / (p1 + p2); wt[gw * 2 + 1] = pg * p2 / (p1 + p2);
    }
}
__global__ void __launch_bounds__(256) k_moe(const float* __restrict__ h2, const int* __restrict__ sel, const float* __restrict__ wt, const float* __restrict__ w1, const float* __restrict__ w3, const float* __restrict__ w2,
                      const float* __restrict__ mod, float* __restrict__ out) {
    __shared__ float sh[D]; __shared__ float hid[2][256];
    const int t = blockIdx.x, tid = threadIdx.x, b = t / T;
    for (int i = 0; i < 4; ++i) sh[tid + 256 * i] = h2[(size_t)t * D + tid + 256 * i];
    __syncthreads();
    for (int s = 0; s < 2; ++s) { const int e = sel[t * 2 + s]; const float w = wt[t * 2 + s];
        const float* p1 = w1 + (size_t)e * D * 256 + tid; const float* p3 = w3 + (size_t)e * D * 256 + tid; float a = 0.f, g = 0.f;
        for (int k = 0; k < D; ++k) { a += sh[k] * p1[(size_t)k * 256]; g += sh[k] * p3[(size_t)k * 256]; }
        hid[s][tid] = siluf(a) * g * w; }
    __syncthreads();
    for (int i = 0; i < 4; ++i) { const int n = tid + 256 * i; float y = 0.f;
        for (int s = 0; s < 2; ++s) { const int e = sel[t * 2 + s]; const float* p2 = w2 + (size_t)e * 256 * D + n;
            for (int f = 0; f < 256; ++f) y += hid[s][f] * p2[(size_t)f * D]; }
        out[(size_t)t * D + n] += mod[b * 6 * D + 5 * D + n] * y; }
}

constexpr size_t O_MOD = 0, O_BUFA = 65536, O_PROJ = O_BUFA + (size_t)M * D, O_LOGA = O_PROJ + (size_t)M * INC,
                 O_SEL = O_LOGA + (size_t)M * 256, O_WT = O_SEL + (size_t)M * 2, O_END = O_WT + (size_t)M * 2;

static void run(void* const* d_in, float* out, float* ws, hipStream_t st) {
    const float *x = (const float*)d_in[0], *c = (const float*)d_in[1], *w_ada = (const float*)d_in[2], *b_ada = (const float*)d_in[3], *g1 = (const float*)d_in[4], *w_in = (const float*)d_in[5],
                *qn = (const float*)d_in[6], *kn = (const float*)d_in[7], *sinks = (const float*)d_in[8], *w_gk2 = (const float*)d_in[9], *b_gk = (const float*)d_in[10], *g_gla = (const float*)d_in[11],
                *g_att = (const float*)d_in[12], *w_out = (const float*)d_in[13], *g2 = (const float*)d_in[14], *w_group = (const float*)d_in[15], *b_group = (const float*)d_in[16], *w_router = (const float*)d_in[17],
                *b_router = (const float*)d_in[18], *w1 = (const float*)d_in[19], *w3 = (const float*)d_in[20], *w2 = (const float*)d_in[21];
    float *mod = ws + O_MOD, *bufA = ws + O_BUFA, *proj = ws + O_PROJ, *loga = ws + O_LOGA, *wt = ws + O_WT; int* sel = (int*)(ws + O_SEL);
    k_mod<<<dim3(6 * D / 256, B), 256, 0, st>>>(c, w_ada, b_ada, mod);
    k_normmod<<<M, 256, 0, st>>>(x, g1, mod, 0, 1, bufA);
    k_gemm<<<dim3((INC + 63) / 64, M / 64), 256, 0, st>>>(bufA, D, w_in, INC, proj, INC, M, INC, D);
    k_headnorm<<<M * 8 / 4, 256, 0, st>>>(proj, C_QA, 8, qn);
    k_headnorm<<<M * 2 / 4, 256, 0, st>>>(proj, C_KA, 2, kn);
    k_attn<<<M * 8 / 4, 256, 0, st>>>(proj, sinks, bufA);
    k_attnorm<<<M / 4, 256, 0, st>>>(bufA, g_att);
    k_loga<<<M * 256 / 256, 256, 0, st>>>(proj, w_gk2, b_gk, loga);
    k_gla<<<B * 4, 128, 0, st>>>(proj, loga, bufA);
    k_glaout<<<M * 4 / 4, 256, 0, st>>>(proj, g_gla, bufA);
    k_gemm<<<dim3(D / 64, M / 64), 256, 0, st>>>(bufA, D, w_out, D, proj, D, M, D, D);
    k_resid<<<(unsigned)(((size_t)M * D + 255) / 256), 256, 0, st>>>(x, proj, mod, 2, out);
    k_normmod<<<M, 256, 0, st>>>(out, g2, mod, 3, 4, bufA);
    k_router<<<M / 4, 256, 0, st>>>(bufA, w_group, b_group, w_router, b_router, sel, wt);
    k_moe<<<M, 256, 0, st>>>(bufA, sel, wt, w1, w3, w2, mod, out);
}
}

extern "C" void kernel_launch(void* const* d_in, const int* in_sizes, int n_in, void* d_out, int out_size, void* d_ws, size_t ws_size, hipStream_t stream) {
    if (ws_size < nv::O_END * 4) { fprintf(stderr, "ws too small: %zu < %zu\n", ws_size, (size_t)nv::O_END * 4); return; }
    nv::run(d_in, (float*)d_out, (float*)d_ws, stream);
}
```

```cpp
#define MK_DEBUG 0
#define MK_PER_PHASE 1

#include <hip/hip_runtime.h>
#include <cstdio>
#include <cstdint>
#include <cmath>

namespace pg8 {
#define PG8_LAS __attribute__((address_space(3)))
typedef unsigned short bf16_t;
typedef short bf16x8 __attribute__((ext_vector_type(8)));
typedef float f32x4 __attribute__((ext_vector_type(4)));
typedef unsigned u32x4 __attribute__((ext_vector_type(4)));
typedef unsigned u32x2 __attribute__((ext_vector_type(2)));
constexpr int BM = 256, BK = 64, HALF = 128, HTB = HALF * BK * 2  , STAGE_BYTES = 8 * HTB, NXCD = 8, WGM = 8;

__host__ __device__ __forceinline__ int lds_byte(int r, int c) { const int st = (r >> 4) * 2 + (c >> 5), rr = r & 15, cc = c & 31, ob = rr * 64 + cc * 2; return st * 1024 + (ob ^ (((ob >> 9) & 1) << 5)); }
__host__ __device__ __forceinline__ void stage_rc(int b, int& R, int& C) { const int st = b / 1024, sb = b % 1024, swz = sb ^ (((sb >> 9) & 1) << 5); R = (st >> 1) * 16 + swz / 64; C = (st & 1) * 32 + (swz % 64) / 2; }
__host__ __device__ __forceinline__ int perm32(int rho) { const int n = rho >> 4, i = rho & 15; return 8 * (i >> 2) + 4 * n + (i & 3); }

struct Unit { int pm, pn, aux, ksplit; const char* a; const char* b0; const char* b1; const int* gidx; };

__device__ __forceinline__ unsigned cvt_pk_bf16(float lo, float hi) { unsigned r; asm volatile("v_cvt_pk_bf16_f32 %0, %1, %2" : "=v"(r) : "v"(lo), "v"(hi)); return r; }

template <class Epi, class Sched, bool ALIGN_EPI, bool GATHER>
__device__ __forceinline__ void gemm_phase(PG8_LAS unsigned char* lds, const int K, const int lda, const int ldb, const Sched& S, const Epi& E) {
    const int tid = threadIdx.x, wid = __builtin_amdgcn_readfirstlane(tid >> 6), lane = tid & 63, wr = wid >> 2, wc = wid & 3, fr = lane & 15, fq = lane >> 4;
    const int nt = K / BK;
    int RA[2]; unsigned colA[2], voffB[2];
    unsigned cvA[2][2];
#pragma unroll
    for (int i = 0; i < 2; ++i) { int R, C; stage_rc(tid * 16 + i * 8192, R, C); const int Rb = Epi::PERM ? ((R & ~31) + perm32(R & 31)) : R;
        RA[i] = R; colA[i] = (unsigned)C * 2u; voffB[i] = (unsigned)(Rb * ldb + C) * 2u; }
    PG8_LAS unsigned* park = (PG8_LAS unsigned*)(lds + STAGE_BYTES) + tid;
    const size_t kstep = (size_t)(BK * 2);
    const size_t hstepB = (size_t)HALF * ldb * 2;
    const unsigned ldsw = (unsigned)wid * 1024u;
    const int aoff = lds_byte(wr * 64 + fr, fq * 8), boff = lds_byte(wc * 32 + fr, fq * 8);
#define PG8_SA(b, h) (((b) * 2 + (h)) * HTB)
#define PG8_SB(b, h) ((4 + (b) * 2 + (h)) * HTB)
#define PG8_STAGE(bufoff, gbase, voff) do { _Pragma("unroll") for (int _i = 0; _i < 2; ++_i) \
        __builtin_amdgcn_global_load_lds((const unsigned*)((const char*)(gbase) + (voff)[_i]), (PG8_LAS unsigned*)(lds + (bufoff) + ldsw + _i * 8192), 16, 0, 0); } while (0)
#define PG8_LDA(dst, b, h) do { _Pragma("unroll") for (int m = 0; m < 4; ++m) _Pragma("unroll") for (int k = 0; k < 2; ++k) dst[m][k] = *(const PG8_LAS bf16x8*)(lds + PG8_SA(b, h) + aoff + m * 2048 + k * 1024); } while (0)
#define PG8_LDB(dst, b, h) do { _Pragma("unroll") for (int n = 0; n < 2; ++n) _Pragma("unroll") for (int k = 0; k < 2; ++k) dst[n][k] = *(const PG8_LAS bf16x8*)(lds + PG8_SB(b, h) + boff + n * 2048 + k * 1024); } while (0)
#define PG8_MMA(ai, bj, At, Bt) do { __builtin_amdgcn_s_setprio(1); _Pragma("unroll") for (int m = 0; m < 4; ++m) _Pragma("unroll") for (int n = 0; n < 2; ++n) _Pragma("unroll") for (int k = 0; k < 2; ++k) \
        acc[ai][bj][m][n] = __builtin_amdgcn_mfma_f32_16x16x32_bf16(Bt[n][k], At[m][k], acc[ai][bj][m][n], 0, 0, 0); __builtin_amdgcn_s_setprio(0); } while (0)
#define PG8_WAIT_V(n) asm volatile("s_waitcnt vmcnt(" #n ")" ::: "memory")
#define PG8_WAIT_L(n) asm volatile("s_waitcnt lgkmcnt(" #n ")" ::: "memory")
#define PG8_BAR __builtin_amdgcn_s_barrier()
#define PG8_SCHED __builtin_amdgcn_sched_barrier(0)
#define PG8_AOFFS(dst, u) do { _Pragma("unroll") for (int _h = 0; _h < 2; ++_h) _Pragma("unroll") for (int _i = 0; _i < 2; ++_i) { \
        const int _r = RA[_i] + _h * HALF; const int _row = GATHER ? ((_r < (u).aux) ? (u).gidx[_r] : 0) : _r; dst[_h][_i] = (unsigned)_row * (unsigned)(lda * 2) + colA[_i]; } } while (0)
#define PG8_BPTR(u, kt) (((kt) < (u).ksplit) ? (u).b0 + (size_t)(kt) * kstep : (u).b1 + (size_t)((kt) - (u).ksplit) * kstep)
    Unit cur, nxt; int ui = 0;
    if (!S.next(0, cur)) return;
    f32x4 acc[2][2][4][2];
#pragma unroll
    for (int a = 0; a < 2; ++a)
#pragma unroll
        for (int b = 0; b < 2; ++b)
#pragma unroll
            for (int m = 0; m < 4; ++m)
#pragma unroll
                for (int n = 0; n < 2; ++n) acc[a][b][m][n] = (f32x4){0.f, 0.f, 0.f, 0.f};
    bf16x8 At[4][2], B0[2][2], B1[2][2];
    const char* cA = cur.a; const char* cB = cur.b0;
    PG8_AOFFS(cvA, cur);
    PG8_STAGE(PG8_SB(0, 0), cB, voffB); PG8_STAGE(PG8_SB(0, 1), cB + hstepB, voffB); PG8_STAGE(PG8_SA(0, 0), cA, cvA[0]); PG8_STAGE(PG8_SA(0, 1), cA, cvA[1]);
    if (wr == 1) PG8_BAR;
    PG8_WAIT_V(2); PG8_BAR;
    PG8_STAGE(PG8_SB(1, 0), cB + kstep, voffB); PG8_STAGE(PG8_SA(1, 0), cA + kstep, cvA[0]); PG8_STAGE(PG8_SB(1, 1), cB + hstepB + kstep, voffB);
    PG8_WAIT_V(6); PG8_BAR;
    for (;;) {
        const bool has_next = S.next(ui + 1, nxt);
        const char* nA = has_next ? nxt.a : cA;
        if (!has_next) nxt = cur;
        if constexpr (GATHER) { unsigned nvA[2][2]; PG8_AOFFS(nvA, nxt);
#pragma unroll
            for (int h = 0; h < 2; ++h)
#pragma unroll
                for (int i = 0; i < 2; ++i) park[(h * 2 + i) * 512] = nvA[h][i]; }
        for (int t = 0; t < nt; t += 2) {
            const bool last = (t == nt - 2);
            const char* a1 = cA + (size_t)(t + 1) * kstep;
            const char* a2 = last ? nA : cA + (size_t)(t + 2) * kstep;
            const char* b2 = last ? PG8_BPTR(nxt, 0) : PG8_BPTR(cur, t + 2);
            const char* a3 = a2 + kstep; const char* b3 = b2 + kstep;
            PG8_LDB(B0, 0, 0); PG8_LDB(B1, 0, 1); PG8_SCHED; PG8_LDA(At, 0, 0); PG8_STAGE(PG8_SA(1, 1), a1, cvA[1]);
            if constexpr (GATHER) { if (last) {
#pragma unroll
                for (int h = 0; h < 2; ++h)
#pragma unroll
                    for (int i = 0; i < 2; ++i) cvA[h][i] = park[(h * 2 + i) * 512]; } }
            PG8_WAIT_V(8); PG8_WAIT_L(0); PG8_BAR; PG8_MMA(0, 0, At, B0); PG8_MMA(0, 1, At, B1); PG8_BAR; PG8_SCHED;
            PG8_LDA(At, 0, 1); PG8_STAGE(PG8_SB(0, 0), b2, voffB); PG8_STAGE(PG8_SB(0, 1), b2 + hstepB, voffB); PG8_STAGE(PG8_SA(0, 0), a2, cvA[0]);
            PG8_WAIT_V(8); PG8_WAIT_L(0); PG8_BAR; PG8_MMA(1, 0, At, B0); PG8_MMA(1, 1, At, B1); PG8_BAR; PG8_SCHED;
            PG8_LDB(B0, 1, 0); PG8_LDB(B1, 1, 1); PG8_SCHED; PG8_LDA(At, 1, 0); PG8_STAGE(PG8_SA(0, 1), a2, cvA[1]);
            PG8_WAIT_V(8); PG8_WAIT_L(0); PG8_BAR; PG8_MMA(0, 0, At, B0); PG8_MMA(0, 1, At, B1); PG8_BAR; PG8_SCHED;
            PG8_LDA(At, 1, 1); PG8_STAGE(PG8_SB(1, 0), b3, voffB); PG8_STAGE(PG8_SB(1, 1), b3 + hstepB, voffB); PG8_STAGE(PG8_SA(1, 0), a3, cvA[0]);
            PG8_WAIT_V(8); PG8_WAIT_L(0); PG8_BAR; PG8_MMA(1, 0, At, B0); PG8_MMA(1, 1, At, B1); PG8_BAR; PG8_SCHED;
        }
        if constexpr (ALIGN_EPI) { if (wr == 0) PG8_BAR; }
        { int fr_ = fr; asm volatile("" : "+v"(fr_)); E(acc, cur, wr, wc, fr_, fq); }
        if (!has_next) break;
#pragma unroll
        for (int a = 0; a < 2; ++a)
#pragma unroll
            for (int b = 0; b < 2; ++b)
#pragma unroll
                for (int m = 0; m < 4; ++m)
#pragma unroll
                    for (int n = 0; n < 2; ++n) acc[a][b][m][n] = (f32x4){0.f, 0.f, 0.f, 0.f};
        cur = nxt; cA = nA; ++ui;
        if constexpr (ALIGN_EPI) { if (wr == 1) PG8_BAR; }
    }
    PG8_WAIT_V(0);
    if constexpr (!ALIGN_EPI) { if (wr == 0) PG8_BAR; }
    PG8_BAR;
#undef PG8_SA
#undef PG8_SB
#undef PG8_STAGE
#undef PG8_LDA
#undef PG8_LDB
#undef PG8_MMA
#undef PG8_WAIT_V
#undef PG8_WAIT_L
#undef PG8_BAR
#undef PG8_SCHED
#undef PG8_AOFFS
#undef PG8_BPTR
}
}

namespace mk {
constexpr int NWAVES = 8;
constexpr int D = 1024, NB = 8, T = 2048, M = NB * T;
constexpr int INC = 2320;
constexpr int NIN = 2560;
constexpr int C_LR = 1792;
constexpr float EPS = 1e-6f, LOG2E = 1.4426950408889634f;
constexpr int NSEG = 8, SEGLEN = T / NSEG, CH = 64, NCH = SEGLEN / CH;
constexpr int NCLS = 24, LCAP = M;
constexpr int MAXTILES = 88;

constexpr size_t MiB = 1u << 20;
constexpr size_t WS_CTL = 0, CTL_ZERO_BYTES = 1 * MiB;
constexpr size_t WS_MOD = 1 * MiB;
constexpr size_t WS_WIN = 2 * MiB;
constexpr size_t WS_WOUT = 7 * MiB;
constexpr size_t WS_W13 = 9 * MiB;
constexpr size_t WS_W2 = 25 * MiB;
constexpr size_t WS_XN = 33 * MiB;
constexpr size_t WS_QA = 65 * MiB;
constexpr size_t WS_KA = 81 * MiB;
constexpr size_t WS_VA = 85 * MiB;
constexpr size_t WS_QG = 89 * MiB;
constexpr size_t WS_KG = 97 * MiB;
constexpr size_t WS_VG = 105 * MiB;
constexpr size_t WS_LA = 121 * MiB;
constexpr size_t WS_OGS = 137 * MiB;
constexpr size_t WS_MIX = 153 * MiB;
constexpr size_t WS_USEG = 185 * MiB;
constexpr size_t WS_DSEG = 193 * MiB;
constexpr size_t WS_LIST = 194 * MiB;
constexpr size_t WS_LW = 196 * MiB;
constexpr size_t WS_HID = 200 * MiB;
constexpr size_t WS_END = 222 * MiB;
constexpr int CW_BAR = 4096;
constexpr int CW_CNT = 16384;

#define GAS __attribute__((address_space(1)))
#define LAS __attribute__((address_space(3)))
typedef unsigned short bf16;
typedef unsigned v4u __attribute__((ext_vector_type(4)));
typedef unsigned v2u __attribute__((ext_vector_type(2)));
typedef float f32x4 __attribute__((ext_vector_type(4)));
typedef float f32x16 __attribute__((ext_vector_type(16)));
typedef short bf16x8 __attribute__((ext_vector_type(8)));
typedef short s16x4 __attribute__((ext_vector_type(4)));
#define RLX_AGENT __ATOMIC_RELAXED, __HIP_MEMORY_SCOPE_AGENT
#define LDS_WAIT() asm volatile("s_waitcnt lgkmcnt(0)" ::: "memory")
#define VM_WAIT() asm volatile("s_waitcnt vmcnt(0)" ::: "memory")
__device__ __forceinline__ unsigned f2bf(float f) { unsigned u = __builtin_bit_cast(unsigned, f); return (u + 0x7fffu + ((u >> 16) & 1u)) >> 16; }
__device__ __forceinline__ unsigned pk2(float lo, float hi) { return f2bf(lo) | (f2bf(hi) << 16); }
__device__ __forceinline__ float bf2f(unsigned short b) { return __builtin_bit_cast(float, (unsigned)b << 16); }
__device__ __forceinline__ float siluf(float v) { return v * __builtin_amdgcn_rcpf(1.f + __expf(-v)); }
__device__ __forceinline__ int crow(int r, int hi) { return (r & 3) + 8 * (r >> 2) + 4 * hi; }
typedef float f32x2_t __attribute__((ext_vector_type(2))); typedef __bf16 bf16x2_t __attribute__((ext_vector_type(2)));
__device__ __forceinline__ unsigned cvtpk(float lo, float hi) { f32x2_t v = {lo, hi}; bf16x2_t b = __builtin_convertvector(v, bf16x2_t); return __builtin_bit_cast(unsigned, b); }
__device__ __forceinline__ bf16x8 pack8(const f32x16& x, int s) {
    v4u p; p.x = cvtpk(x[8 * s], x[8 * s + 1]); p.y = cvtpk(x[8 * s + 2], x[8 * s + 3]); p.z = cvtpk(x[8 * s + 4], x[8 * s + 5]); p.w = cvtpk(x[8 * s + 6], x[8 * s + 7]);
    return __builtin_bit_cast(bf16x8, p);
}
#define MFMA32(a, b, c) __builtin_amdgcn_mfma_f32_32x32x16_bf16((a), (b), (c), 0, 0, 0)

struct Args { const float* in[22]; float* out; unsigned char* ws; int ph_lo, ph_hi; };

struct Frame {
    LAS unsigned char* lds;
    unsigned* ctl;
    int tid, lane, wave, vcu, G;
    const float* in[22]; float* out; unsigned char* ws;
};
__device__ __forceinline__ float wave_sum(float v) {
#pragma unroll
    for (int o = 1; o < 64; o <<= 1) v += __shfl_xor(v, o);
    return v;
}
}

namespace mk {
#define XB_TMO      128
#define XB_XCNT(j)  (256  + 64 * (j))
#define XB_XSUB(j)  (1280 + 64 * (j))
#define XB_XGEN(j)  (2304 + 64 * (j))
#define XB_TOP      3328
#define XB_TOPGEN   3392
#define XCD_BAR_WORDS 3456
#define XB_SPIN_CAP (1u << 18)

__device__ __forceinline__ unsigned xb_ld(unsigned* p)              { return __hip_atomic_load(p, __ATOMIC_RELAXED, __HIP_MEMORY_SCOPE_AGENT); }
__device__ __forceinline__ unsigned xb_add(unsigned* p, unsigned v) { return __hip_atomic_fetch_add(p, v, __ATOMIC_RELAXED, __HIP_MEMORY_SCOPE_AGENT); }
__device__ __forceinline__ unsigned xb_xcc_id() { return (unsigned)__builtin_amdgcn_s_getreg((3 << 11) | 20) & 0xFu; }
#define XB_SPIN(cond, bar) do { unsigned _sp = 0; while (cond) { __builtin_amdgcn_s_sleep(1); \
    if ((++_sp & 255u) == 0u) { if (xb_ld(&(bar)[XB_TMO])) break; if (_sp > XB_SPIN_CAP) { atomicAdd(&(bar)[XB_TMO], 1u); break; } } } } while (0)

struct XcdBarrier {
    unsigned* bar; unsigned x;
    volatile LAS unsigned* st;
};

__device__ __forceinline__ XcdBarrier xcd_barrier_post(unsigned* bar, volatile LAS unsigned* st) {
    XcdBarrier b; b.bar = bar; b.x = xb_xcc_id(); b.st = st;
    if (threadIdx.x == 0) (void)xb_add(&bar[XB_XCNT(b.x)], 1u);
    return b;
}
__device__ __forceinline__ void xcd_barrier_complete(unsigned* bar, unsigned x, unsigned& nloc, unsigned& nx) {
    const unsigned G = gridDim.x * gridDim.y * gridDim.z;
    unsigned sum, cnt, mine, sp = 0u;
    for (;;) {
        sum = 0u; cnt = 0u; mine = 0u;
#pragma unroll
        for (unsigned j = 0; j < 16; ++j) { const unsigned c = xb_ld(&bar[XB_XCNT(j)]); sum += c; cnt += (c > 0u) ? 1u : 0u; mine = (j == x) ? c : mine; }
        if (sum == G) break;
        __builtin_amdgcn_s_sleep(1);
        if ((++sp & 255u) == 0u) { if (xb_ld(&bar[XB_TMO])) break; if (sp > XB_SPIN_CAP) { atomicAdd(&bar[XB_TMO], 1u); break; } }
    }
    nloc = mine > 0u ? mine : 1u; nx = cnt > 0u ? cnt : 1u;
}

__device__ __forceinline__ void xcd_barrier(const XcdBarrier& b) {
    asm volatile("s_waitcnt vmcnt(0)" ::: "memory");
    __syncthreads();
    if (threadIdx.x == 0) {
        unsigned* bar = b.bar;
        __builtin_amdgcn_s_waitcnt(0);
        unsigned nloc = b.st[0], nx = b.st[1];
        if (nloc == 0u) { xcd_barrier_complete(bar, b.x, nloc, nx); b.st[0] = nloc; b.st[1] = nx; }
        const unsigned old = xb_add(&bar[XB_XSUB(b.x)], 1u);
        const unsigned gen = old / nloc;
        if (old + 1u == (gen + 1u) * nloc) {
            __builtin_amdgcn_fence(__ATOMIC_RELEASE, "agent");
            asm volatile("s_waitcnt vmcnt(0)" ::: "memory");
            const unsigned og = xb_add(&bar[XB_TOP], 1u);
            const unsigned tg = og / nx;
            if (og + 1u == (tg + 1u) * nx) xb_add(&bar[XB_TOPGEN], 1u);
            else XB_SPIN(xb_ld(&bar[XB_TOPGEN]) == tg, bar);
            __builtin_amdgcn_fence(__ATOMIC_ACQUIRE, "agent");
            xb_add(&bar[XB_XGEN(b.x)], 1u);
            asm volatile("s_waitcnt vmcnt(0)" ::: "memory");
        } else {
            XB_SPIN(xb_ld(&bar[XB_XGEN(b.x)]) == gen, bar);
            __builtin_amdgcn_fence(__ATOMIC_ACQUIRE, "agent");
            asm volatile("s_waitcnt vmcnt(0)" ::: "memory");
        }
    }
    __syncthreads();
}

}

namespace mk {
template <class SrcF>
__device__ __forceinline__ void transpose_item(SrcF src, bf16* dst, int ldd, int r0d, int k0d, LAS float* scr, int lane) {
#pragma unroll 8
    for (int i = 0; i < 32; ++i) { const int kk = 2 * i + (lane >> 5); scr[kk * 33 + (lane & 31)] = src(kk, lane & 31); }
    LDS_WAIT(); asm volatile("" ::: "memory");
    const int c = lane & 7;
#pragma unroll
    for (int j = 0; j < 4; ++j) { const int n = (lane >> 3) + 8 * j; const LAS float* s = scr + (8 * c) * 33 + n;
        v4u o; o.x = pk2(s[0 * 33], s[1 * 33]); o.y = pk2(s[2 * 33], s[3 * 33]); o.z = pk2(s[4 * 33], s[5 * 33]); o.w = pk2(s[6 * 33], s[7 * 33]);
        *(v4u*)(dst + (size_t)(r0d + n) * ldd + k0d + 8 * c) = o; }
    LDS_WAIT(); asm volatile("" ::: "memory");
}
__device__ __forceinline__ int win_src_base(int pn) { return pn < 7 ? 256 * pn : (pn == 7 ? -1 : 1808 + 256 * (pn - 8)); }

__device__ __forceinline__ void p0_prologue(Frame& F) {
    const float* c = F.in[1]; const float* w_ada = F.in[2]; const float* b_ada = F.in[3];
    if (F.vcu < 96) {
        LAS float* sc = (LAS float*)F.lds; LAS float* red = (LAS float*)(F.lds + 32768);
        for (int e = F.tid; e < 8 * 1024; e += NWAVES * 64) { const int b = e >> 10, k = e & 1023; sc[k * 8 + b] = siluf(c[b * D + k]); }
        __syncthreads();
        const int j = 64 * F.vcu + F.lane; float acc[8];
#pragma unroll
        for (int b = 0; b < 8; ++b) acc[b] = 0.f;
        const float* wp = w_ada + (size_t)(128 * F.wave) * (6 * D) + j;
#pragma unroll 8
        for (int kk = 0; kk < 128; ++kk) { const float wv = wp[(size_t)kk * (6 * D)]; const f32x4 s0 = *(const LAS f32x4*)(sc + (128 * F.wave + kk) * 8), s1 = *(const LAS f32x4*)(sc + (128 * F.wave + kk) * 8 + 4);
            acc[0] += s0.x * wv; acc[1] += s0.y * wv; acc[2] += s0.z * wv; acc[3] += s0.w * wv; acc[4] += s1.x * wv; acc[5] += s1.y * wv; acc[6] += s1.z * wv; acc[7] += s1.w * wv; }
#pragma unroll
        for (int b = 0; b < 8; ++b) red[(F.wave * 8 + b) * 64 + F.lane] = acc[b];
        __syncthreads();
        { const int b = F.wave; float s = 0.f;
#pragma unroll
          for (int w = 0; w < 8; ++w) s += red[(w * 8 + b) * 64 + F.lane];
          ((float*)(F.ws + WS_MOD))[b * 6 * D + j] = s + b_ada[j]; }
        __syncthreads();
    }
    LAS float* scr = (LAS float*)(F.lds + F.wave * 16384);
    const int gw = F.vcu * NWAVES + F.wave, NGW = F.G * NWAVES;
    const float* w_in = F.in[5]; const float* w_gk2 = F.in[9]; const float* g_att = F.in[12]; const float* w_out = F.in[13];
    const float* w1 = F.in[19]; const float* w3 = F.in[20]; const float* w2 = F.in[21];
    bf16* WIN = (bf16*)(F.ws + WS_WIN); bf16* WOUT = (bf16*)(F.ws + WS_WOUT); bf16* W13 = (bf16*)(F.ws + WS_W13); bf16* W2T = (bf16*)(F.ws + WS_W2);
    constexpr int I_IN = 10 * 8 * 16, I_OUT = 32 * 16, I_13 = 16 * 16 * 16, I_2 = 16 * 32 * 4, NITEMS = I_IN + I_OUT + I_13 + I_2;
    for (int it = gw; it < NITEMS; it += NGW) {
        int r = it;
        if (r < I_IN) { const int kb = r & 15, g = (r >> 4) & 7, pn = r >> 7; const int o0 = 64 * (g & 3) + 32 * (g >> 2), sb = win_src_base(pn), k0 = 64 * kb;
            if (sb >= 0) { const float* sp = w_in + (size_t)k0 * INC + sb + o0; transpose_item([&](int kk, int nn) { return sp[(size_t)kk * INC + nn]; }, WIN, D, 256 * pn + 32 * g, k0, scr, F.lane); }
            else { const float* lp = w_in + (size_t)k0 * INC + C_LR; const float* gp = w_gk2 + o0;
                transpose_item([&](int kk, int nn) { float z = 0.f;
#pragma unroll
                    for (int rr = 0; rr < 16; ++rr) z += lp[(size_t)kk * INC + rr] * gp[rr * 256 + nn]; return z; }, WIN, D, 256 * pn + 32 * g, k0, scr, F.lane); }
            continue; }
        r -= I_IN;
        if (r < I_OUT) { const int kb = r & 15, nb = r >> 4, k0 = 64 * kb; const float* sp = w_out + (size_t)k0 * D + 32 * nb;
            if (k0 < 512) transpose_item([&](int kk, int nn) { return sp[(size_t)kk * D + nn] * g_att[k0 + kk]; }, WOUT, D, 32 * nb, k0, scr, F.lane);
            else transpose_item([&](int kk, int nn) { return sp[(size_t)kk * D + nn]; }, WOUT, D, 32 * nb, k0, scr, F.lane);
            continue; }
        r -= I_OUT;
        if (r < I_13) { const int kb = r & 15, rg = (r >> 4) & 15, e = r >> 8, k0 = 64 * kb; const int hh = rg >> 3, ctg = rg & 7, f0 = 128 * hh + 32 * (ctg & 3);
            const float* sp = (ctg < 4 ? w1 : w3) + (size_t)e * D * 256 + (size_t)k0 * 256 + f0;
            transpose_item([&](int kk, int nn) { return sp[(size_t)kk * 256 + nn]; }, W13, D, e * 512 + 32 * rg, k0, scr, F.lane);
            continue; }
        r -= I_13;
        { const int kb = r & 3, nb = (r >> 2) & 31, e = r >> 7, k0 = 64 * kb; const float* sp = w2 + (size_t)e * 256 * D + (size_t)k0 * D + 32 * nb;
          transpose_item([&](int kk, int nn) { return sp[(size_t)kk * D + nn]; }, W2T, 256, e * 1024 + 32 * nb, k0, scr, F.lane); }
    }
}

__device__ __forceinline__ void normmod_row(const float* xrow, const float* g, const float* scale, const float* shift, bf16* orow, int lane, f32x4 (&hv)[4]) {
    const f32x4* xr = (const f32x4*)xrow + lane; f32x4 v[4]; float s = 0.f;
#pragma unroll
    for (int j = 0; j < 4; ++j) { v[j] = xr[64 * j]; s += (v[j].x * v[j].x + v[j].y * v[j].y) + (v[j].z * v[j].z + v[j].w * v[j].w); }
    const float rstd = rsqrtf(wave_sum(s) * (1.f / D) + EPS);
    unsigned long long* o8 = (unsigned long long*)orow + lane;
#pragma unroll
    for (int j = 0; j < 4; ++j) { const f32x4 gg = ((const f32x4*)g)[lane + 64 * j], sc = ((const f32x4*)scale)[lane + 64 * j], sh = ((const f32x4*)shift)[lane + 64 * j];
        f32x4 h; h.x = v[j].x * rstd * gg.x * (1.f + sc.x) + sh.x; h.y = v[j].y * rstd * gg.y * (1.f + sc.y) + sh.y; h.z = v[j].z * rstd * gg.z * (1.f + sc.z) + sh.z; h.w = v[j].w * rstd * gg.w * (1.f + sc.w) + sh.w;
        hv[j] = h; o8[64 * j] = (unsigned long long)pk2(h.x, h.y) | ((unsigned long long)pk2(h.z, h.w) << 32); }
}
__device__ __forceinline__ void p1_norm1(Frame& F) {
    const int gw = F.vcu * NWAVES + F.wave, NGW = F.G * NWAVES; const float* mod = (const float*)(F.ws + WS_MOD); bf16* XN = (bf16*)(F.ws + WS_XN);
    for (int m = gw; m < M; m += NGW) { const int b = m / T; f32x4 hv[4];
        normmod_row(F.in[0] + (size_t)m * D, F.in[4], mod + b * 6 * D + 1 * D, mod + b * 6 * D + 0 * D, XN + (size_t)m * D, F.lane, hv); }
}

struct SchedStatic {
    int nM, nN, nwg, G, c, nt; const char* A; const char* B; size_t a_tile, b_tile;
    __device__ void init(int Mm, int N, int K, int lda, int ldb, const void* A_, const void* B_, int G_, int c_) { nM = Mm / 256; nN = N / 256; nwg = nM * nN; G = G_; c = c_; nt = K / 64; A = (const char*)A_; B = (const char*)B_;
        a_tile = (size_t)256 * lda * 2; b_tile = (size_t)256 * ldb * 2; }
    __device__ bool next(int i, pg8::Unit& u) const {
        const long L = (long)i * G + c; if (L >= nwg) return false;
        int wgid = (int)L; { const int q = nwg / 8, r = nwg % 8, xcd = wgid % 8, off = wgid / 8; wgid = (xcd < r ? xcd * (q + 1) : r * (q + 1) + (xcd - r) * q) + off; }
        const int nig = 8 * nN, gid = wgid / nig, fm = gid * 8, gsz = (nM - fm) < 8 ? (nM - fm) : 8;
        u.pm = fm + ((wgid % nig) % gsz); u.pn = (wgid % nig) / gsz; u.aux = 0; u.ksplit = nt;
        u.a = A + (size_t)u.pm * a_tile; u.b0 = B + (size_t)u.pn * b_tile; u.b1 = u.b0; u.gidx = nullptr; return true;
    }
};

struct EpiInProj {
    static constexpr bool PERM = true;
    bf16 *QA, *KA, *VA, *QG, *KG, *VG, *OGS; float* LA; const float *qn, *kn, *bgk;
    __device__ __forceinline__ void operator()(const f32x4 (&acc)[2][2][4][2], const pg8::Unit& u, int wr, int wc, int fr, int fq) const {
        const int pn = u.pn; const int row0 = u.pm * 256 + wr * 64 + fr; const int cw = 8 * fq;
        if (pn < 2 || (pn == 2 && wc < 2)) {
            const float* gw = pn < 2 ? qn : kn; const float mul = pn < 2 ? 0.125f * LOG2E : 1.f;
            f32x4 gv[2][2];
#pragma unroll
            for (int bj = 0; bj < 2; ++bj)
#pragma unroll
                for (int n = 0; n < 2; ++n) gv[bj][n] = *(const f32x4*)(gw + 32 * bj + cw + 4 * n) * mul;
            bf16* base = pn < 2 ? QA + 256 * pn + 64 * wc : KA + 64 * wc; const int ld = pn < 2 ? 512 : 128;
#pragma unroll
            for (int ai = 0; ai < 2; ++ai)
#pragma unroll
                for (int m = 0; m < 4; ++m) { float s = 0.f;
#pragma unroll
                    for (int bj = 0; bj < 2; ++bj)
#pragma unroll
                        for (int n = 0; n < 2; ++n) { const f32x4 v = acc[ai][bj][m][n]; s += (v.x * v.x + v.y * v.y) + (v.z * v.z + v.w * v.w); }
                    s += __shfl_xor(s, 16); s += __shfl_xor(s, 32);
                    const float r = rsqrtf(s * (1.f / 64.f) + EPS);
                    bf16* rowp = base + (size_t)(row0 + ai * 128 + m * 16) * ld + cw;
#pragma unroll
                    for (int bj = 0; bj < 2; ++bj) { const f32x4 v0 = acc[ai][bj][m][0] * gv[bj][0] * r, v1 = acc[ai][bj][m][1] * gv[bj][1] * r;
                        v4u w; w.x = cvtpk(v0.x, v0.y); w.y = cvtpk(v0.z, v0.w); w.z = cvtpk(v1.x, v1.y); w.w = cvtpk(v1.z, v1.w); *(v4u*)(rowp + 32 * bj) = w; } }
            return;
        }
        if (pn == 7) {
            f32x4 bv[2][2];
#pragma unroll
            for (int bj = 0; bj < 2; ++bj)
#pragma unroll
                for (int n = 0; n < 2; ++n) bv[bj][n] = *(const f32x4*)(bgk + 64 * wc + 32 * bj + cw + 4 * n);
#pragma unroll
            for (int ai = 0; ai < 2; ++ai)
#pragma unroll
                for (int m = 0; m < 4; ++m) { float* rowp = LA + (size_t)(row0 + ai * 128 + m * 16) * 256 + 64 * wc + cw;
#pragma unroll
                    for (int bj = 0; bj < 2; ++bj)
#pragma unroll
                        for (int n = 0; n < 2; ++n) { const f32x4 z = acc[ai][bj][m][n] + bv[bj][n]; f32x4 o;
#pragma unroll
                            for (int j = 0; j < 4; ++j) o[j] = (fminf(z[j], 0.f) - __logf(1.f + __expf(-fabsf(z[j])))) * (1.f / 16.f);
                            *(f32x4*)(rowp + 32 * bj + 4 * n) = o; } }
            return;
        }
        bf16* base; int ld; int mode = 0;
        if (pn == 2) { base = VA + 64 * (wc - 2); ld = 128; }
        else if (pn == 3) { base = QG + 64 * wc; ld = 256; mode = 1; }
        else if (pn == 4) { base = KG + 64 * wc; ld = 256; }
        else if (pn < 7) { base = VG + 256 * (pn - 5) + 64 * wc; ld = 512; }
        else { base = OGS + 256 * (pn - 8) + 64 * wc; ld = 512; mode = 2; }
#pragma unroll
        for (int ai = 0; ai < 2; ++ai)
#pragma unroll
            for (int m = 0; m < 4; ++m) { bf16* rowp = base + (size_t)(row0 + ai * 128 + m * 16) * ld + cw;
#pragma unroll
                for (int bj = 0; bj < 2; ++bj) { f32x4 v0 = acc[ai][bj][m][0], v1 = acc[ai][bj][m][1];
                    if (mode == 1) { v0 = v0 * 0.125f; v1 = v1 * 0.125f; }
                    if (mode == 2) {
#pragma unroll
                        for (int j = 0; j < 4; ++j) { v0[j] = siluf(v0[j]); v1[j] = siluf(v1[j]); } }
                    v4u w; w.x = cvtpk(v0.x, v0.y); w.y = cvtpk(v0.z, v0.w); w.z = cvtpk(v1.x, v1.y); w.w = cvtpk(v1.z, v1.w); *(v4u*)(rowp + 32 * bj) = w; } }
    }
};
}

namespace mk {
typedef short v4i16_t __attribute__((ext_vector_type(4)));
__device__ __forceinline__ s16x4 lds_tr16(const LAS bf16* p) { return __builtin_bit_cast(s16x4, __builtin_amdgcn_ds_read_tr16_b64_v4i16((LAS v4i16_t*)p)); }
__device__ __forceinline__ bf16x8 cat8(s16x4 lo, s16x4 hi) { return __builtin_shufflevector(lo, hi, 0, 1, 2, 3, 4, 5, 6, 7); }
__device__ __forceinline__ bf16x8 lds_b128(const LAS bf16* p) { return *(const LAS bf16x8*)p; }
__device__ __forceinline__ s16x4 lds_b64(const LAS bf16* p) { return *(const LAS s16x4*)p; }

constexpr int GP = 72;
constexpr int GL_QT = 0, GL_KT = 9216, GL_KHT = 18432, GL_VT = 27648, GL_EXPB = 46080, GL_TOT = 46336, GL_RED = 48384, GL_END = 49408;
template <bool FULL>
__device__ __forceinline__ void gla_item(Frame& F, int item) {
    const int bh = item / NSEG, seg = item % NSEG, b = bh >> 2, h = bh & 3;
    const int tid = F.tid, lane = F.lane, wave = F.wave, r = lane & 31, hi = lane >> 5;
    LAS bf16* QT = (LAS bf16*)(F.lds + GL_QT); LAS bf16* KT = (LAS bf16*)(F.lds + GL_KT); LAS bf16* KHT = (LAS bf16*)(F.lds + GL_KHT); LAS bf16* VT = (LAS bf16*)(F.lds + GL_VT);
    LAS float* EXPB = (LAS float*)(F.lds + GL_EXPB); LAS float* TOT = (LAS float*)(F.lds + GL_TOT); LAS float* RED = (LAS float*)(F.lds + GL_RED);
    const bf16* QG = (const bf16*)(F.ws + WS_QG); const bf16* KG = (const bf16*)(F.ws + WS_KG); const bf16* VG = (const bf16*)(F.ws + WS_VG); const bf16* OGS = (const bf16*)(F.ws + WS_OGS);
    const float* LA = (const float*)(F.ws + WS_LA); float* USEG = (float*)(F.ws + WS_USEG); float* DSEG = (float*)(F.ws + WS_DSEG); bf16* MIX = (bf16*)(F.ws + WS_MIX);
    const float* g_gla = F.in[11];
    const int e0 = 32 * (wave & 3);
    f32x16 S[2];
#pragma unroll
    for (int dt = 0; dt < 2; ++dt)
#pragma unroll
        for (int i = 0; i < 16; ++i) S[dt][i] = 0.f;
    if (FULL && wave < 4) {
        for (int sp = 0; sp < seg; ++sp) { const float* U = USEG + (size_t)(item - seg + sp) * 8192; const float* Dv = DSEG + (size_t)(item - seg + sp) * 64;
#pragma unroll
            for (int dt = 0; dt < 2; ++dt)
#pragma unroll
                for (int i = 0; i < 16; ++i) { const int d = 32 * dt + crow(i, hi); S[dt][i] = Dv[d] * S[dt][i] + U[d * 128 + e0 + r]; } }
    }
    float sumB = 0.f;
    for (int c = 0; c < NCH; ++c) {
        const int tok0 = b * T + seg * SEGLEN + c * CH;
        const int sg = wave, d = lane; float p[8]; float run = 0.f;
#pragma unroll
        for (int tt = 0; tt < 8; ++tt) { run += LA[(size_t)(tok0 + 8 * sg + tt) * 256 + 64 * h + d]; p[tt] = run; }
        TOT[sg * 64 + d] = run;
        { const int e = tid & 127, jq = tid >> 7; unsigned w[8];
#pragma unroll
          for (int jj = 0; jj < 8; ++jj) { const unsigned lo = VG[(size_t)(tok0 + 16 * jq + 2 * jj) * 512 + 128 * h + e], hi2 = VG[(size_t)(tok0 + 16 * jq + 2 * jj + 1) * 512 + 128 * h + e]; w[jj] = lo | (hi2 << 16); }
          *(LAS v4u*)(VT + e * GP + 16 * jq) = (v4u){w[0], w[1], w[2], w[3]}; *(LAS v4u*)(VT + e * GP + 16 * jq + 8) = (v4u){w[4], w[5], w[6], w[7]}; }
        __syncthreads();
        float off = 0.f, Bl = 0.f;
#pragma unroll
        for (int s2 = 0; s2 < 8; ++s2) { const float tv = TOT[s2 * 64 + d]; Bl += tv; if (s2 < sg) off += tv; }
        { float kh[8];
#pragma unroll
          for (int tt = 0; tt < 8; ++tt) { const float bb = off + p[tt]; const int j = 8 * sg + tt; const float kv = bf2f(KG[(size_t)(tok0 + j) * 256 + 64 * h + d]);
              if (FULL) { const float qv = bf2f(QG[(size_t)(tok0 + j) * 256 + 64 * h + d]); QT[j * GP + d] = (bf16)f2bf(qv * __expf(bb)); KT[j * GP + d] = (bf16)f2bf(kv * __expf(-bb)); }
              kh[tt] = kv * __expf(Bl - bb); }
          *(LAS v4u*)(KHT + d * GP + 8 * sg) = (v4u){pk2(kh[0], kh[1]), pk2(kh[2], kh[3]), pk2(kh[4], kh[5]), pk2(kh[6], kh[7])}; }
        if (sg == 0) { EXPB[d] = __expf(Bl); sumB += Bl; }
        __syncthreads();
        f32x16 O0, O1;
        if (wave < 4) {
            if (FULL) {
                f32x16 A00, A01, A11;
#pragma unroll
                for (int i = 0; i < 16; ++i) { A00[i] = 0.f; A01[i] = 0.f; A11[i] = 0.f; O0[i] = 0.f; O1[i] = 0.f; }
#pragma unroll
                for (int s = 0; s < 4; ++s) { const bf16x8 kf0 = lds_b128(KT + r * GP + 16 * s + 8 * hi), kf1 = lds_b128(KT + (32 + r) * GP + 16 * s + 8 * hi);
                    const bf16x8 qf0 = lds_b128(QT + r * GP + 16 * s + 8 * hi), qf1 = lds_b128(QT + (32 + r) * GP + 16 * s + 8 * hi);
                    A00 = MFMA32(kf0, qf0, A00); A01 = MFMA32(kf0, qf1, A01); A11 = MFMA32(kf1, qf1, A11); }
#pragma unroll
                for (int i = 0; i < 16; ++i) { if (crow(i, hi) > r) { A00[i] = 0.f; A11[i] = 0.f; } }
#pragma unroll
                for (int s2 = 0; s2 < 2; ++s2) {
                    const bf16x8 va0 = cat8(lds_b64(VT + (e0 + r) * GP + 16 * s2 + 4 * hi), lds_b64(VT + (e0 + r) * GP + 16 * s2 + 8 + 4 * hi));
                    const bf16x8 va1 = cat8(lds_b64(VT + (e0 + r) * GP + 32 + 16 * s2 + 4 * hi), lds_b64(VT + (e0 + r) * GP + 32 + 16 * s2 + 8 + 4 * hi));
                    O0 = MFMA32(va0, pack8(A00, s2), O0); O1 = MFMA32(va0, pack8(A01, s2), O1); O1 = MFMA32(va1, pack8(A11, s2), O1); }
#pragma unroll
                for (int dt = 0; dt < 2; ++dt)
#pragma unroll
                    for (int s2 = 0; s2 < 2; ++s2) { const bf16x8 sa = pack8(S[dt], s2);
                        const bf16x8 qb0 = cat8(lds_b64(QT + r * GP + 32 * dt + 16 * s2 + 4 * hi), lds_b64(QT + r * GP + 32 * dt + 16 * s2 + 8 + 4 * hi));
                        const bf16x8 qb1 = cat8(lds_b64(QT + (32 + r) * GP + 32 * dt + 16 * s2 + 4 * hi), lds_b64(QT + (32 + r) * GP + 32 * dt + 16 * s2 + 8 + 4 * hi));
                        O0 = MFMA32(sa, qb0, O0); O1 = MFMA32(sa, qb1, O1); }
            }
#pragma unroll
            for (int dt = 0; dt < 2; ++dt)
#pragma unroll
                for (int i = 0; i < 16; ++i) S[dt][i] *= EXPB[32 * dt + crow(i, hi)];
#pragma unroll
            for (int s = 0; s < 4; ++s) { const bf16x8 vb = lds_b128(VT + (e0 + r) * GP + 16 * s + 8 * hi);
#pragma unroll
                for (int dt = 0; dt < 2; ++dt) { const bf16x8 ka = lds_b128(KHT + (32 * dt + r) * GP + 16 * s + 8 * hi); S[dt] = MFMA32(ka, vb, S[dt]); } }
            if (FULL) {
                float s0 = 0.f, s1 = 0.f;
#pragma unroll
                for (int i = 0; i < 16; ++i) { s0 += O0[i] * O0[i]; s1 += O1[i] * O1[i]; }
                s0 += __shfl_xor(s0, 32); s1 += __shfl_xor(s1, 32);
                if (hi == 0) { RED[wave * 64 + r] = s0; RED[wave * 64 + 32 + r] = s1; }
            }
        }
        __syncthreads();
        if (FULL && wave < 4) {
#pragma unroll
            for (int it = 0; it < 2; ++it) { const int i = 32 * it + r; const float tot = (RED[i] + RED[64 + i]) + (RED[128 + i] + RED[192 + i]); const float rstd = rsqrtf(tot * (1.f / 128.f) + EPS);
                const size_t tok = (size_t)(tok0 + i);
#pragma unroll
                for (int rg = 0; rg < 4; ++rg) { const int e = e0 + 8 * rg + 4 * hi; const v2u og = *(const v2u*)(OGS + tok * 512 + 128 * h + e); const f32x4 gg = *(const f32x4*)(g_gla + e);
                    const float o0 = (it ? O1[4 * rg] : O0[4 * rg]), o1 = (it ? O1[4 * rg + 1] : O0[4 * rg + 1]), o2 = (it ? O1[4 * rg + 2] : O0[4 * rg + 2]), o3 = (it ? O1[4 * rg + 3] : O0[4 * rg + 3]);
                    const float y0 = o0 * rstd * gg.x * bf2f((bf16)(og.x & 0xffffu)), y1 = o1 * rstd * gg.y * bf2f((bf16)(og.x >> 16)), y2 = o2 * rstd * gg.z * bf2f((bf16)(og.y & 0xffffu)), y3 = o3 * rstd * gg.w * bf2f((bf16)(og.y >> 16));
                    *(v2u*)(MIX + tok * 1024 + 512 + 128 * h + e) = (v2u){cvtpk(y0, y1), cvtpk(y2, y3)}; } }
        }
    }
    if (!FULL) {
        if (wave < 4) { float* U = USEG + (size_t)item * 8192;
#pragma unroll
            for (int dt = 0; dt < 2; ++dt)
#pragma unroll
                for (int i = 0; i < 16; ++i) U[(32 * dt + crow(i, hi)) * 128 + e0 + r] = S[dt][i]; }
        if (wave == 0) DSEG[(size_t)item * 64 + lane] = __expf(sumB);
    }
    __syncthreads();
}

constexpr int AT_KS = 0, AT_VS = 46080, AT_RED = 92160, AT_END = 93184;
__device__ __forceinline__ void attn_unit(Frame& F, int unit) {
    const int b = unit >> 6, tb = unit & 63, t0 = 32 * tb, tok0 = b * T + t0;
    const int tid = F.tid, lane = F.lane, r = lane & 31, hi = lane >> 5, hq = F.wave, kvh = hq >> 2;
    LAS bf16* KS = (LAS bf16*)(F.lds + AT_KS); LAS bf16* VS = (LAS bf16*)(F.lds + AT_VS); LAS float* RED = (LAS float*)(F.lds + AT_RED);
    const bf16* QA = (const bf16*)(F.ws + WS_QA); const bf16* KA = (const bf16*)(F.ws + WS_KA); const bf16* VA = (const bf16*)(F.ws + WS_VA); bf16* MIX = (bf16*)(F.ws + WS_MIX);
    const int kt_lo = (t0 >= 128) ? 0 : (128 - t0) / 32;
    { const int nch = (5 - kt_lo) * 32 * 16;
      for (int c = tid; c < nch; c += NWAVES * 64) { const int row = (c >> 4) + 32 * kt_lo, part = c & 15, kv = part >> 3, col8 = part & 7; const size_t tok = (size_t)(tok0 - 128 + row);
          const v4u kk = *(const v4u*)(KA + tok * 128 + part * 8), vv = *(const v4u*)(VA + tok * 128 + part * 8);
          *(LAS v4u*)(KS + (kv * 160 + row) * GP + col8 * 8) = kk; *(LAS v4u*)(VS + (kv * 160 + row) * GP + col8 * 8) = vv; } }
    __syncthreads();
    const float slope2 = exp2f(-(float)(hq + 1)) * LOG2E, sink2 = F.in[8][hq] * LOG2E;
    bf16x8 qf[4];
#pragma unroll
    for (int s = 0; s < 4; ++s) qf[s] = *(const bf16x8*)(QA + (size_t)(tok0 + r) * 512 + 64 * hq + 16 * s + 8 * hi);
    f32x16 st[5];
#pragma unroll
    for (int kt = 0; kt < 5; ++kt) {
#pragma unroll
        for (int i = 0; i < 16; ++i) st[kt][i] = 0.f;
        if (kt >= kt_lo) {
#pragma unroll
            for (int s = 0; s < 4; ++s) st[kt] = MFMA32(lds_b128(KS + (kvh * 160 + 32 * kt + r) * GP + 16 * s + 8 * hi), qf[s], st[kt]); }
    }
    float m = sink2;
#pragma unroll
    for (int kt = 0; kt < 5; ++kt)
#pragma unroll
        for (int i = 0; i < 16; ++i) { const int dist = 128 - 32 * kt + r - crow(i, hi); const bool valid = (kt >= kt_lo) && dist >= 0 && dist < 128;
            const float v = valid ? st[kt][i] - slope2 * (float)dist : -INFINITY; st[kt][i] = v; m = fmaxf(m, v); }
    m = fmaxf(m, __shfl_xor(m, 32));
    float l = 0.f;
#pragma unroll
    for (int kt = 0; kt < 5; ++kt)
#pragma unroll
        for (int i = 0; i < 16; ++i) { const float pv = exp2f(st[kt][i] - m); st[kt][i] = pv; l += pv; }
    l += __shfl_xor(l, 32); l += exp2f(sink2 - m);
    f32x16 O[2];
#pragma unroll
    for (int dt = 0; dt < 2; ++dt)
#pragma unroll
        for (int i = 0; i < 16; ++i) O[dt][i] = 0.f;
    const int g16 = lane >> 4, q4 = (lane & 15) >> 2, p4 = lane & 3;
#pragma unroll
    for (int kt = 0; kt < 5; ++kt) {
        if (kt >= kt_lo) {
#pragma unroll
            for (int s2 = 0; s2 < 2; ++s2) { const bf16x8 pb = pack8(st[kt], s2);
#pragma unroll
                for (int dt = 0; dt < 2; ++dt) { const LAS bf16* vp = VS + (kvh * 160 + 32 * kt + 16 * s2 + 4 * hi + q4) * GP + 32 * dt + 16 * (g16 & 1) + 4 * p4;
                    const bf16x8 va = cat8(lds_tr16(vp), lds_tr16(vp + 8 * GP)); O[dt] = MFMA32(va, pb, O[dt]); } } }
    }
    const float inv = 1.f / l; float ss = 0.f;
#pragma unroll
    for (int dt = 0; dt < 2; ++dt)
#pragma unroll
        for (int i = 0; i < 16; ++i) { O[dt][i] *= inv; ss += O[dt][i] * O[dt][i]; }
    ss += __shfl_xor(ss, 32);
    if (hi == 0) RED[hq * 32 + r] = ss;
    __syncthreads();
    float tot = 0.f;
#pragma unroll
    for (int hh = 0; hh < 8; ++hh) tot += RED[hh * 32 + r];
    const float rstd = rsqrtf(tot * (1.f / 512.f) + EPS);
#pragma unroll
    for (int dt = 0; dt < 2; ++dt)
#pragma unroll
        for (int rg = 0; rg < 4; ++rg) { const int dd = 32 * dt + 8 * rg + 4 * hi;
            *(v2u*)(MIX + (size_t)(tok0 + r) * 1024 + 64 * hq + dd) = (v2u){cvtpk(O[dt][4 * rg] * rstd, O[dt][4 * rg + 1] * rstd), cvtpk(O[dt][4 * rg + 2] * rstd, O[dt][4 * rg + 3] * rstd)}; }
    __syncthreads();
}
}

namespace mk {
struct EpiOut {
    static constexpr bool PERM = false;
    const float* x; float* out; const float* gate;
    __device__ __forceinline__ void operator()(const f32x4 (&acc)[2][2][4][2], const pg8::Unit& u, int wr, int wc, int fr, int fq) const {
        const int row0 = u.pm * 256 + wr * 64 + fr, col0 = u.pn * 256 + wc * 32 + 4 * fq, b = (u.pm * 256) / T;
        f32x4 gv[2][2];
#pragma unroll
        for (int bj = 0; bj < 2; ++bj)
#pragma unroll
            for (int n = 0; n < 2; ++n) gv[bj][n] = *(const f32x4*)(gate + b * 6 * D + col0 + bj * 128 + n * 16);
#pragma unroll
        for (int ai = 0; ai < 2; ++ai)
#pragma unroll
            for (int m = 0; m < 4; ++m) { const size_t off = (size_t)(row0 + ai * 128 + m * 16) * D + col0;
#pragma unroll
                for (int bj = 0; bj < 2; ++bj)
#pragma unroll
                    for (int n = 0; n < 2; ++n) { const f32x4 xv = *(const f32x4*)(x + off + bj * 128 + n * 16); *(f32x4*)(out + off + bj * 128 + n * 16) = xv + gv[bj][n] * acc[ai][bj][m][n]; } }
    }
};

__device__ __forceinline__ void p6_route(Frame& F) {
    LAS float* WR = (LAS float*)F.lds;
    const float* w_group = F.in[15]; const float* b_group = F.in[16]; const float* w_router = F.in[17]; const float* b_router = F.in[18];
    for (int e = F.tid; e < 1024 * 20; e += NWAVES * 64) { const int k = e / 20, i = e % 20; WR[e] = i < 4 ? w_group[k * 4 + i] : w_router[k * 16 + i - 4]; }
    __syncthreads();
    const int gw = F.vcu * NWAVES + F.wave, NGW = F.G * NWAVES; const float* mod = (const float*)(F.ws + WS_MOD); bf16* XN = (bf16*)(F.ws + WS_XN);
    unsigned* cnt = F.ctl + CW_CNT; int* LIST = (int*)(F.ws + WS_LIST); float* LW = (float*)(F.ws + WS_LW);
    for (int m = gw; m < M; m += NGW) { const int b = m / T; f32x4 hv[4];
        normmod_row(F.out + (size_t)m * D, F.in[14], mod + b * 6 * D + 4 * D, mod + b * 6 * D + 3 * D, XN + (size_t)m * D, F.lane, hv);
        float acc[20];
#pragma unroll
        for (int i = 0; i < 20; ++i) acc[i] = 0.f;
#pragma unroll
        for (int j = 0; j < 4; ++j)
#pragma unroll
            for (int q = 0; q < 4; ++q) { const int k = 256 * j + 4 * F.lane + q; const float hvv = hv[j][q]; const LAS f32x4* wp = (const LAS f32x4*)(WR + k * 20);
#pragma unroll
                for (int c4 = 0; c4 < 5; ++c4) { const f32x4 w = wp[c4]; acc[4 * c4] += hvv * w.x; acc[4 * c4 + 1] += hvv * w.y; acc[4 * c4 + 2] += hvv * w.z; acc[4 * c4 + 3] += hvv * w.w; }
                if (q & 1) __builtin_amdgcn_sched_barrier(0); }
#pragma unroll
        for (int i = 0; i < 20; ++i) acc[i] = wave_sum(acc[i]);
        if (F.lane == 0) {
            float gl[4]; int gs = 0;
#pragma unroll
            for (int i = 0; i < 4; ++i) gl[i] = acc[i] + b_group[i];
#pragma unroll
            for (int i = 1; i < 4; ++i) if (gl[i] > gl[gs]) gs = i;
            float den = 0.f;
#pragma unroll
            for (int i = 0; i < 4; ++i) den += __expf(gl[i] - gl[gs]);
            const float pg = 1.f / den;
            float el[4];
#pragma unroll
            for (int i = 0; i < 4; ++i) { float v = acc[4 + i] + b_router[i]; v = gs == 1 ? acc[8 + i] + b_router[4 + i] : v; v = gs == 2 ? acc[12 + i] + b_router[8 + i] : v; v = gs == 3 ? acc[16 + i] + b_router[12 + i] : v; el[i] = v; }
            int i1 = 0;
#pragma unroll
            for (int i = 1; i < 4; ++i) if (el[i] > el[i1]) i1 = i;
            int i2 = -1;
#pragma unroll
            for (int i = 0; i < 4; ++i) { if (i != i1 && (i2 < 0 || el[i] > el[i2])) i2 = i; }
            float e1v = el[0], e2v = el[0];
#pragma unroll
            for (int i = 1; i < 4; ++i) { e1v = (i == i1) ? el[i] : e1v; e2v = (i == i2) ? el[i] : e2v; }
            if (i1 == 0) e1v = el[0];
            if (i2 == 0) e2v = el[0];
            const float p2 = __expf(e2v - e1v); const float w1v = pg / (1.f + p2), w2v = pg * p2 / (1.f + p2);
            const int lo = i1 < i2 ? i1 : i2, hi = i1 < i2 ? i2 : i1; const float wlo = i1 < i2 ? w1v : w2v, whi = i1 < i2 ? w2v : w1v;
            const int pidx = lo == 0 ? hi - 1 : (lo == 1 ? 1 + hi : 5); const int cls = gs * 6 + pidx;
            const unsigned slot = __hip_atomic_fetch_add(cnt + cls, 1u, RLX_AGENT);
            LIST[(size_t)cls * LCAP + slot] = m; LW[((size_t)cls * LCAP + slot) * 2] = wlo; LW[((size_t)cls * LCAP + slot) * 2 + 1] = whi;
        }
    }
}

__device__ __forceinline__ void cls_experts(int cls, int& elo, int& ehi) { const int g = cls / 6, p = cls % 6; const int lo = p < 3 ? 0 : (p < 5 ? 1 : 2), hi = p < 3 ? p + 1 : (p < 5 ? p - 1 : 3); elo = 4 * g + lo; ehi = 4 * g + hi; }
template <bool PHASE_B>
struct SchedMoe {
    const unsigned* cnt; int G, c; const char* XN; const char* HID; const char* W13; const char* W2T; const int* LIST;
    __device__ bool next(int i, pg8::Unit& u) const {
        const int L = i * G + c; const int tau = L >> 2, pn = L & 3;
        int base = 0, cls = -1, r0 = 0, valid = 0;
        for (int cc = 0; cc < NCLS; ++cc) { const int n = (int)cnt[cc]; const int ntile = (n + 255) >> 8;
            if (cls < 0 && tau < base + ntile) { cls = cc; r0 = (tau - base) * 256; valid = n - r0 < 256 ? n - r0 : 256; }
            base += ntile; }
        if (cls < 0) return false;
        int elo, ehi; cls_experts(cls, elo, ehi);
        u.pm = tau; u.pn = pn; u.aux = valid; u.gidx = LIST + (size_t)cls * LCAP + r0;
        if (!PHASE_B) { u.a = XN; u.ksplit = 16; const int e = pn < 2 ? elo : ehi; u.b0 = W13 + ((size_t)(e * 512 + 256 * (pn & 1)) * D) * 2; u.b1 = u.b0; }
        else { u.a = HID + (size_t)tau * 256 * 512 * 2; u.ksplit = 4; u.b0 = W2T + ((size_t)(elo * 1024 + 256 * pn) * 256) * 2; u.b1 = W2T + ((size_t)(ehi * 1024 + 256 * pn) * 256) * 2; }
        return true;
    }
};
struct EpiMoeA {
    static constexpr bool PERM = true;
    bf16* HID; const int* LIST; const float* LW;
    __device__ __forceinline__ void operator()(const f32x4 (&acc)[2][2][4][2], const pg8::Unit& u, int wr, int wc, int fr, int fq) const {
        const float* lw = LW + (size_t)(u.gidx - LIST) * 2 + (u.pn >> 1);
        bf16* base = HID + (size_t)u.pm * 256 * 512 + 256 * (u.pn >> 1) + 128 * (u.pn & 1) + 32 * wc + 8 * fq;
#pragma unroll
        for (int ai = 0; ai < 2; ++ai)
#pragma unroll
            for (int m = 0; m < 4; ++m) { const int r = ai * 128 + wr * 64 + m * 16 + fr; const float w = lw[2 * r];
                const f32x4 a0 = acc[ai][0][m][0], a1 = acc[ai][0][m][1], g0 = acc[ai][1][m][0], g1 = acc[ai][1][m][1]; f32x4 h0, h1;
#pragma unroll
                for (int j = 0; j < 4; ++j) { h0[j] = siluf(a0[j]) * g0[j] * w; h1[j] = siluf(a1[j]) * g1[j] * w; }
                v4u o; o.x = cvtpk(h0.x, h0.y); o.y = cvtpk(h0.z, h0.w); o.z = cvtpk(h1.x, h1.y); o.w = cvtpk(h1.z, h1.w);
                *(v4u*)(base + (size_t)r * 512) = o; }
    }
};
struct EpiMoeB {
    static constexpr bool PERM = false;
    float* out; const float* gate;
    __device__ __forceinline__ void operator()(const f32x4 (&acc)[2][2][4][2], const pg8::Unit& u, int wr, int wc, int fr, int fq) const {
        const int col0 = u.pn * 256 + wc * 32 + 4 * fq;
#pragma unroll
        for (int ai = 0; ai < 2; ++ai)
#pragma unroll
            for (int m = 0; m < 4; ++m) { const int r = ai * 128 + wr * 64 + m * 16 + fr;
                if (r < u.aux) { const int tok = u.gidx[r]; const int b = tok / T; float* op = out + (size_t)tok * D + col0; const float* gp = gate + b * 6 * D + col0;
#pragma unroll
                    for (int bj = 0; bj < 2; ++bj)
#pragma unroll
                        for (int n = 0; n < 2; ++n) { const f32x4 xv = *(const f32x4*)(op + bj * 128 + n * 16), gv = *(const f32x4*)(gp + bj * 128 + n * 16); *(f32x4*)(op + bj * 128 + n * 16) = xv + gv * acc[ai][bj][m][n]; } } }
    }
};
}

namespace mk {
constexpr int RING_BYTES = 131072, PARK_BYTES = 8192, LDSCTL_OFF = RING_BYTES + PARK_BYTES, MISC_OFF = LDSCTL_OFF + 320, LDS_BYTES = 147456;
constexpr int N_PHASES = 9;

__global__ void __launch_bounds__(NWAVES * 64, 2) mk_fwd(Args args) {
    extern __shared__ __attribute__((aligned(16))) unsigned char lds[];
    Frame F;
    F.lds = (LAS unsigned char*)lds;
    F.tid = threadIdx.x; F.lane = F.tid & 63; F.wave = __builtin_amdgcn_readfirstlane(F.tid >> 6);
    F.G = gridDim.x; { const int bx = blockIdx.x; F.vcu = (F.G % 8 == 0) ? (bx % 8) * (F.G / 8) + bx / 8 : bx; }
    F.ws = args.ws; F.out = args.out; F.ctl = (unsigned*)(args.ws + WS_CTL);
#pragma unroll
    for (int i = 0; i < 22; ++i) F.in[i] = args.in[i];
    for (int u = F.tid; u < (LDS_BYTES - LDSCTL_OFF) / 4; u += NWAVES * 64) ((LAS unsigned*)(F.lds + LDSCTL_OFF))[u] = 0u;
    __syncthreads();
    const int lo = args.ph_lo, hi = args.ph_hi;
    const bool multi = (hi - lo) > 1;
    XcdBarrier bar; bar.bar = F.ctl + CW_BAR; bar.x = 0; bar.st = nullptr;
    if (multi) bar = xcd_barrier_post(F.ctl + CW_BAR, (volatile LAS unsigned*)(F.lds + MISC_OFF) + 8);
#ifndef MK_PHASE_MASK
#define MK_PHASE_MASK 0x1ff
#endif
#define IN(k) (((MK_PHASE_MASK >> (k)) & 1) && lo <= (k) && (k) < hi)
#define SEAM(k) do { if (IN(k) && IN((k) + 1)) xcd_barrier(bar); } while (0)
    const float* mod = (const float*)(F.ws + WS_MOD);

    if (IN(0)) { p0_prologue(F); } SEAM(0);
    if (IN(1)) { p1_norm1(F); } SEAM(1);
    if (IN(2)) {
        SchedStatic S; S.init(M, NIN, D, D, D, F.ws + WS_XN, F.ws + WS_WIN, F.G, (int)blockIdx.x);
        EpiInProj E{(bf16*)(F.ws + WS_QA), (bf16*)(F.ws + WS_KA), (bf16*)(F.ws + WS_VA), (bf16*)(F.ws + WS_QG), (bf16*)(F.ws + WS_KG), (bf16*)(F.ws + WS_VG), (bf16*)(F.ws + WS_OGS), (float*)(F.ws + WS_LA), F.in[6], F.in[7], F.in[10]};
        pg8::gemm_phase<EpiInProj, SchedStatic, true, false>(F.lds, D, D, D, S, E);
    } SEAM(2);
    if (IN(3)) {
        for (int item = F.vcu; item < NB * 4 * NSEG; item += F.G) gla_item<false>(F, item);
        for (int unit = F.vcu; unit < NB * (T / 32); unit += F.G) attn_unit(F, unit);
    } SEAM(3);
    if (IN(4)) {
        for (int item = F.vcu; item < NB * 4 * NSEG; item += F.G) gla_item<true>(F, item);
    } SEAM(4);
    if (IN(5)) {
        SchedStatic S; S.init(M, D, D, D, D, F.ws + WS_MIX, F.ws + WS_WOUT, F.G, (int)blockIdx.x);
        EpiOut E{F.in[0], F.out, mod + 2 * D};
        pg8::gemm_phase<EpiOut, SchedStatic, true, false>(F.lds, D, D, D, S, E);
    } SEAM(5);
    if (IN(6)) { p6_route(F); } SEAM(6);
    if (IN(7)) {
        SchedMoe<false> S{F.ctl + CW_CNT, F.G, F.vcu, (const char*)(F.ws + WS_XN), (const char*)(F.ws + WS_HID), (const char*)(F.ws + WS_W13), (const char*)(F.ws + WS_W2), (const int*)(F.ws + WS_LIST)};
        EpiMoeA E{(bf16*)(F.ws + WS_HID), (const int*)(F.ws + WS_LIST), (const float*)(F.ws + WS_LW)};
        pg8::gemm_phase<EpiMoeA, SchedMoe<false>, true, true>(F.lds, D, D, D, S, E);
    } SEAM(7);
    if (IN(8)) {
        SchedMoe<true> S{F.ctl + CW_CNT, F.G, F.vcu, (const char*)(F.ws + WS_XN), (const char*)(F.ws + WS_HID), (const char*)(F.ws + WS_W13), (const char*)(F.ws + WS_W2), (const int*)(F.ws + WS_LIST)};
        EpiMoeB E{F.out, mod + 5 * D};
        pg8::gemm_phase<EpiMoeB, SchedMoe<true>, true, false>(F.lds, 512, 512, 256, S, E);
    }
#undef IN
#undef SEAM
}
}

#ifndef MK_DEBUG
#define MK_DEBUG 0
#endif
#ifndef MK_PER_PHASE
#define MK_PER_PHASE 0
#endif
#if MK_DEBUG
namespace dbg {
using namespace mk;
__global__ void k_check(const void* fast, int fast_bf16, int fast_ld, const float* ref, int ref_ld, int rows, int cols, const float* colscale, float refscale, int ref_silu, float* stats) {
    float e2 = 0.f, r2 = 0.f;
    for (size_t idx = (size_t)blockIdx.x * blockDim.x + threadIdx.x; idx < (size_t)rows * cols; idx += (size_t)gridDim.x * blockDim.x) {
        const int r = (int)(idx / cols), c = (int)(idx % cols);
        float f = fast_bf16 ? bf2f(((const bf16*)fast)[(size_t)r * fast_ld + c]) : ((const float*)fast)[(size_t)r * fast_ld + c];
        if (colscale) f *= colscale[c];
        float rv = ref[(size_t)r * ref_ld + c]; if (ref_silu) rv = rv / (1.f + __expf(-rv)); rv *= refscale;
        const float d = f - rv; e2 += d * d; r2 += rv * rv; }
    e2 = wave_sum(e2); r2 = wave_sum(r2);
    if ((threadIdx.x & 63) == 0) { atomicAdd(stats, e2); atomicAdd(stats + 1, r2); }
}
__global__ void k_final(const float* stats, int nstage, float tol, float* out, size_t n) {
    float code = 0.f;
    for (int s = 1; s <= nstage; ++s) { const float e2 = stats[2 * s], r2 = stats[2 * s + 1]; const float ratio = e2 / r2;
        if (!(ratio <= tol)) { int bucket = 5; if (ratio < 1e-3f) bucket = 0; else if (ratio < 1e-2f) bucket = 1; else if (ratio < 1e-1f) bucket = 2; else if (ratio < 1.f) bucket = 3; else if (ratio < 1e30f) bucket = 4;
            code = 1000.f * (float)(10 * s + bucket); break; } }
    for (size_t idx = (size_t)blockIdx.x * blockDim.x + threadIdx.x; idx < n; idx += (size_t)gridDim.x * blockDim.x) out[idx] = idx == 0 ? code : 0.f;
}
}
#endif

extern "C" void kernel_launch(void* const* d_in, const int* in_sizes, int n_in, void* d_out, int out_size, void* d_ws, size_t ws_size, hipStream_t stream) {
    using namespace mk;
    static int grid = 0;
    if (grid == 0) {
        if (n_in != 22 || out_size != M * D || ws_size < 256 * MiB) { fprintf(stderr, "kernel_launch: unexpected sizes n_in %d out %d ws %zu\n", n_in, out_size, ws_size); grid = -1; return; }
        int dev = 0, cus = 0, per_cu = 0;
        if (hipGetDevice(&dev) != hipSuccess || hipDeviceGetAttribute(&cus, hipDeviceAttributeMultiprocessorCount, dev) != hipSuccess) { grid = -1; return; }
        if (hipFuncSetAttribute((const void*)mk_fwd, hipFuncAttributeMaxDynamicSharedMemorySize, LDS_BYTES) != hipSuccess) { fprintf(stderr, "kernel_launch: hipFuncSetAttribute failed\n"); grid = -1; return; }
        if (hipOccupancyMaxActiveBlocksPerMultiprocessor(&per_cu, (const void*)mk_fwd, NWAVES * 64, LDS_BYTES) != hipSuccess || per_cu < 1) fprintf(stderr, "kernel_launch: occupancy query reports %d\n", per_cu);
        (void)hipGetLastError();
        grid = cus;
    }
    if (grid < 0) return;
    (void)hipMemsetAsync((char*)d_ws + WS_CTL, 0, CTL_ZERO_BYTES, stream);
    Args a{};
    for (int i = 0; i < 22; ++i) a.in[i] = (const float*)d_in[i];
    a.out = (float*)d_out; a.ws = (unsigned char*)d_ws;
#if !MK_DEBUG
#if MK_PER_PHASE
    for (int p = 0; p < N_PHASES; ++p) { a.ph_lo = p; a.ph_hi = p + 1; hipLaunchKernelGGL(mk_fwd, dim3(grid), dim3(NWAVES * 64), LDS_BYTES, stream, a); }
#else
    a.ph_lo = 0; a.ph_hi = N_PHASES; hipLaunchKernelGGL(mk_fwd, dim3(grid), dim3(NWAVES * 64), LDS_BYTES, stream, a);
#endif
#else
    auto fast = [&](int lo, int hi) { for (int p = lo; p < hi; ++p) { a.ph_lo = p; a.ph_hi = p + 1; hipLaunchKernelGGL(mk_fwd, dim3(grid), dim3(NWAVES * 64), LDS_BYTES, stream, a); } };
    unsigned char* ws = (unsigned char*)d_ws; float* nws = (float*)(ws + 224 * MiB);
    float* n_mod = nws; float* n_bufA = nws + 65536; float* n_proj = n_bufA + (size_t)T * D; float* n_loga = n_proj + (size_t)T * nv::INC; int* n_sel = (int*)(n_loga + (size_t)T * 256); float* n_wt = (float*)(n_sel + T * 2);
    float* n_out = (float*)(ws + WS_QA);
    float* stats = (float*)(ws + 512 * 1024);
    const float *x = (const float*)d_in[0], *c = (const float*)d_in[1], *w_ada = (const float*)d_in[2], *b_ada = (const float*)d_in[3], *g1 = (const float*)d_in[4], *w_in = (const float*)d_in[5],
                *qn = (const float*)d_in[6], *kn = (const float*)d_in[7], *sinks = (const float*)d_in[8], *w_gk2 = (const float*)d_in[9], *b_gk = (const float*)d_in[10], *g_gla = (const float*)d_in[11],
                *g_att = (const float*)d_in[12], *w_out = (const float*)d_in[13], *g2 = (const float*)d_in[14], *w_group = (const float*)d_in[15], *b_group = (const float*)d_in[16], *w_router = (const float*)d_in[17],
                *b_router = (const float*)d_in[18], *w1 = (const float*)d_in[19], *w3 = (const float*)d_in[20], *w2 = (const float*)d_in[21];
    auto chk = [&](int stage, const void* f, int isbf, int fld, const float* ref, int rld, int rows, int cols, const float* cs, float rs, int rsilu) {
        dbg::k_check<<<256, 256, 0, stream>>>(f, isbf, fld, ref, rld, rows, cols, cs, rs, rsilu, stats + 2 * stage); };
    fast(0, 2);
    nv::k_mod<<<dim3(6 * D / 256, NB), 256, 0, stream>>>(c, w_ada, b_ada, n_mod);
    nv::k_normmod<<<T, 256, 0, stream>>>(x, g1, n_mod, 0, 1, n_bufA);
    chk(1, ws + WS_MOD, 0, 6 * D, n_mod, 6 * D, NB, 6 * D, nullptr, 1.f, 0);
    chk(2, ws + WS_XN, 1, D, n_bufA, D, T, D, nullptr, 1.f, 0);
    fast(2, 3);
    nv::k_gemm<<<dim3((nv::INC + 63) / 64, T / 64), 256, 0, stream>>>(n_bufA, D, w_in, nv::INC, n_proj, nv::INC, T, nv::INC, D);
    nv::k_headnorm<<<T * 8 / 4, 256, 0, stream>>>(n_proj, nv::C_QA, 8, qn);
    nv::k_headnorm<<<T * 2 / 4, 256, 0, stream>>>(n_proj, nv::C_KA, 2, kn);
    nv::k_loga<<<T * 256 / 256, 256, 0, stream>>>(n_proj, w_gk2, b_gk, n_loga);
    chk(3, ws + WS_QA, 1, 512, n_proj + nv::C_QA, nv::INC, T, 512, nullptr, 0.125f * LOG2E, 0);
    chk(3, ws + WS_KA, 1, 128, n_proj + nv::C_KA, nv::INC, T, 128, nullptr, 1.f, 0);
    chk(3, ws + WS_VA, 1, 128, n_proj + nv::C_VA, nv::INC, T, 128, nullptr, 1.f, 0);
    chk(4, ws + WS_QG, 1, 256, n_proj + nv::C_QG, nv::INC, T, 256, nullptr, 0.125f, 0);
    chk(4, ws + WS_KG, 1, 256, n_proj + nv::C_KG, nv::INC, T, 256, nullptr, 1.f, 0);
    chk(4, ws + WS_VG, 1, 512, n_proj + nv::C_VG, nv::INC, T, 512, nullptr, 1.f, 0);
    chk(4, ws + WS_LA, 0, 256, n_loga, 256, T, 256, nullptr, 1.f, 0);
    chk(4, ws + WS_OGS, 1, 512, n_proj + nv::C_OG, nv::INC, T, 512, nullptr, 1.f, 1);
    fast(3, 5);
    nv::k_attn<<<T * 8 / 4, 256, 0, stream>>>(n_proj, sinks, n_bufA);
    nv::k_attnorm<<<T / 4, 256, 0, stream>>>(n_bufA, g_att);
    nv::k_gla<<<4, 128, 0, stream>>>(n_proj, n_loga, n_bufA);
    nv::k_glaout<<<T * 4 / 4, 256, 0, stream>>>(n_proj, g_gla, n_bufA);
    chk(5, ws + WS_MIX, 1, D, n_bufA, D, T, 512, g_att, 1.f, 0);
    chk(6, ws + WS_MIX + 512 * 2, 1, D, n_bufA + 512, D, T, 512, nullptr, 1.f, 0);
    fast(5, 6);
    nv::k_gemm<<<dim3(D / 64, T / 64), 256, 0, stream>>>(n_bufA, D, w_out, D, n_proj, D, T, D, D);
    nv::k_resid<<<(unsigned)(((size_t)T * D + 255) / 256), 256, 0, stream>>>(x, n_proj, n_mod, 2, n_out);
    chk(7, d_out, 0, D, n_out, D, T, D, nullptr, 1.f, 0);
    fast(6, 7);
    nv::k_normmod<<<T, 256, 0, stream>>>(n_out, g2, n_mod, 3, 4, n_bufA);
    chk(8, ws + WS_XN, 1, D, n_bufA, D, T, D, nullptr, 1.f, 0);
    fast(7, 9);
    nv::k_router<<<T / 4, 256, 0, stream>>>(n_bufA, w_group, b_group, w_router, b_router, n_sel, n_wt);
    nv::k_moe<<<T, 256, 0, stream>>>(n_bufA, n_sel, n_wt, w1, w3, w2, n_mod, n_out);
    chk(9, d_out, 0, D, n_out, D, T, D, nullptr, 1.f, 0);
    dbg::k_final<<<1024, 256, 0, stream>>>(stats, 9, 3e-4f, (float*)d_out, (size_t)M * D);
#endif
}
```
